# Optimizing an MI355X kernel written in HIP

```python
import math
import jax, jax.numpy as jnp
from jax import lax
import numpy as np


D_MODEL = 1024
BATCH = 2
SEQ = 8192
DEPTH = 4
DEC_BATCH = 128
DEC_SEQ = 8
PAST_LEN = 8192
PAGE_SIZE = 128

N_A_LAYERS = DEPTH // 2
N_B_LAYERS = DEPTH - N_A_LAYERS
FFN_DIM = 2816
CONV_DIM = D_MODEL
CONV_WIDTH = 3
N_HEADS = 16
N_KV_HEADS = 4
HEAD_DIM = 64
GROUP = N_HEADS // N_KV_HEADS
ATTN_DIM = N_HEADS * HEAD_DIM
WINDOW = 128
REL_BUCKETS = 32
REL_MAX_DIST = 128
MEM_TOKENS = 256
MEM_HEADS = 4
MEM_HEAD_DIM = 128
MEM_DIM = MEM_HEADS * MEM_HEAD_DIM
RMS_EPS = 1e-5

kernel_name = 'yoco_shortconv_swa_sink_macaron_memory_step'


def rms_norm(x, g):
    xf = x.astype(jnp.float32)
    y = xf * lax.rsqrt(jnp.mean(xf * xf, axis=-1, keepdims=True) + RMS_EPS)
    return (y * g.astype(jnp.float32)).astype(x.dtype)


def swiglu(h, wg, wu, wd):
    return (jax.nn.silu(h @ wg) * (h @ wu)) @ wd


def t5_bucket(dist):
    n = jnp.maximum(dist, 0)
    exact = REL_BUCKETS // 2
    nf = jnp.maximum(n, 1).astype(jnp.float32)
    large = exact + (jnp.log(nf / exact) / math.log(REL_MAX_DIST / exact)
                     * (REL_BUCKETS - exact)).astype(jnp.int32)
    large = jnp.minimum(large, REL_BUCKETS - 1)
    return jnp.where(n < exact, n, large)


def short_conv(u, prefix, w):
    t = u.shape[1]
    up = jnp.concatenate([prefix.astype(u.dtype), u], axis=1)
    out = sum(w[i].astype(u.dtype) * up[:, i:i + t] for i in range(CONV_WIDTH))
    return out, up[:, -(CONV_WIDTH - 1):]


def memory_kv(mem, g, w):
    b, m, _ = mem.shape
    k, v = jnp.split(rms_norm(mem, g) @ w, 2, axis=-1)
    return (k.reshape(b, m, MEM_HEADS, MEM_HEAD_DIM), v.reshape(b, m, MEM_HEADS, MEM_HEAD_DIM))


def memory_attention(q, mk, mv):
    b, t = q.shape[:2]
    s = jnp.einsum('bthd,bmhd->bhtm', q, mk).astype(jnp.float32) * (MEM_HEAD_DIM ** -0.5)
    p = jax.nn.softmax(s, axis=-1).astype(mv.dtype)
    return jnp.einsum('bhtm,bmhd->bthd', p, mv).reshape(b, t, MEM_DIM)


def sink_window_attention(q, k, v, dist, valid, rel_bias, sinks):
    tq, tk = dist.shape
    s = jnp.einsum('bnqhgd,bnkhd->bnhgqk', q, k).astype(jnp.float32) * (HEAD_DIM ** -0.5)
    bias = rel_bias.astype(jnp.float32)[t5_bucket(dist)]
    bias = bias.reshape(tq, tk, N_KV_HEADS, GROUP).transpose(2, 3, 0, 1)
    mask = valid[None, :, None, None] & ((dist >= 0) & (dist < WINDOW))
    s = jnp.where(mask, s + bias, -jnp.inf)
    sink = sinks.astype(jnp.float32).reshape(N_KV_HEADS, GROUP)[:, :, None, None]
    m = jnp.maximum(jnp.max(s, axis=-1, keepdims=True), sink)
    p = jnp.exp(s - m)
    p = p / (jnp.sum(p, axis=-1, keepdims=True) + jnp.exp(sink - m))
    return jnp.einsum('bnhgqk,bnkhd->bnqhgd', p.astype(v.dtype), v)


def trunk(x, conv_prefix, swa_past_k, swa_past_v, mem_k, mem_v, W):
    b, t, _ = x.shape
    conv_states = []
    for l in range(DEPTH):
        if l == N_A_LAYERS:
            k_new, v_new = jnp.split(rms_norm(x, W['kv_norm']) @ W['w_kv'], 2, axis=-1)
            k_new = k_new.reshape(b, t, N_KV_HEADS, HEAD_DIM)
            v_new = v_new.reshape(b, t, N_KV_HEADS, HEAD_DIM)
            if swa_past_k is None:
                nb = t // WINDOW
                q_block = WINDOW
                kb = k_new.reshape(b, nb, WINDOW, N_KV_HEADS, HEAD_DIM)
                vb = v_new.reshape(b, nb, WINDOW, N_KV_HEADS, HEAD_DIM)
                kprev = jnp.concatenate([jnp.zeros_like(kb[:, :1]), kb[:, :-1]], axis=1)
                vprev = jnp.concatenate([jnp.zeros_like(vb[:, :1]), vb[:, :-1]], axis=1)
                keys = jnp.concatenate([kprev, kb], axis=2)
                vals = jnp.concatenate([vprev, vb], axis=2)
                valid = (jnp.arange(nb)[:, None, None] > 0) | (jnp.arange(2 * WINDOW)[None, None, :] >= WINDOW)
                swa_k_state = k_new[:, -WINDOW:]
                swa_v_state = v_new[:, -WINDOW:]
            else:
                q_block = t
                keys_flat = jnp.concatenate([swa_past_k.astype(k_new.dtype), k_new], axis=1)
                vals_flat = jnp.concatenate([swa_past_v.astype(v_new.dtype), v_new], axis=1)
                keys = keys_flat[:, None]
                vals = vals_flat[:, None]
                valid = jnp.ones((1, 1, WINDOW + t), dtype=bool)
                swa_k_state = keys_flat[:, -WINDOW:]
                swa_v_state = vals_flat[:, -WINDOW:]
            dist = WINDOW + jnp.arange(q_block)[:, None] - jnp.arange(keys.shape[2])[None, :]
        x = x + 0.5 * swiglu(rms_norm(x, W['ffn1_norm'][l]), W['ffn1_wg'][l], W['ffn1_wu'][l], W['ffn1_wd'][l])
        h = rms_norm(x, W['mix_norm'][l])
        if l < N_A_LAYERS:
            z = h @ W['w_in_a'][l]
            b_g, c_g, xin, qm = jnp.split(z, [CONV_DIM, 2 * CONV_DIM, 3 * CONV_DIM], axis=-1)
            conv_out, st = short_conv(c_g * xin, conv_prefix[l], W['conv_w'][l])
            conv_states.append(st)
            y_tok = b_g * conv_out
            w_out = W['w_out_a'][l]
        else:
            j = l - N_A_LAYERS
            z = h @ W['w_in_b'][j]
            qa, qm = jnp.split(z, [ATTN_DIM], axis=-1)
            qa = qa.reshape(b, t // q_block, q_block, N_KV_HEADS, GROUP, HEAD_DIM)
            o = sink_window_attention(qa, keys, vals, dist, valid, W['rel_bias'], W['attn_sinks'][j])
            y_tok = o.reshape(b, t, ATTN_DIM)
            w_out = W['w_out_b'][j]
        y_mem = memory_attention(qm.reshape(b, t, MEM_HEADS, MEM_HEAD_DIM), mem_k[l], mem_v[l])
        x = x + jnp.concatenate([y_tok, y_mem], axis=-1) @ w_out
        x = x + 0.5 * swiglu(rms_norm(x, W['ffn2_norm'][l]), W['ffn2_wg'][l], W['ffn2_wu'][l], W['ffn2_wd'][l])
    return rms_norm(x, W['final_norm']), jnp.stack(conv_states), swa_k_state, swa_v_state


def setup_inputs(seed: int = 0) -> dict:
    key = jax.random.key(seed)
    ks = iter(jax.random.split(key, 40))
    f32 = jnp.float32
    D = D_MODEL

    def nrm(shape, scale):
        return jax.random.normal(next(ks), shape, f32) * scale

    def gain(shape):
        return 1.0 + 0.05 * jax.random.normal(next(ks), shape, f32)

    return {
        'x_prompt': nrm((BATCH, SEQ, D), 1.0),
        'x_sample': nrm((DEC_BATCH, DEC_SEQ, D), 1.0),
        'state_conv': nrm((N_A_LAYERS, DEC_BATCH, CONV_WIDTH - 1, CONV_DIM), 1.0),
        'cache_swa_k': nrm((DEC_BATCH, WINDOW, N_KV_HEADS, HEAD_DIM), 1.0),
        'cache_swa_v': nrm((DEC_BATCH, WINDOW, N_KV_HEADS, HEAD_DIM), 1.0),
        'cache_mem_k': nrm((DEPTH, DEC_BATCH, MEM_TOKENS, MEM_HEADS, MEM_HEAD_DIM), 1.0),
        'cache_mem_v': nrm((DEPTH, DEC_BATCH, MEM_TOKENS, MEM_HEADS, MEM_HEAD_DIM), 1.0),
        'mem_prompt': nrm((BATCH, MEM_TOKENS, D), 1.0),
        'ffn1_norm': gain((DEPTH, D)),
        'ffn1_wg': nrm((DEPTH, D, FFN_DIM), D ** -0.5),
        'ffn1_wu': nrm((DEPTH, D, FFN_DIM), D ** -0.5),
        'ffn1_wd': nrm((DEPTH, FFN_DIM, D), FFN_DIM ** -0.5),
        'mix_norm': gain((DEPTH, D)),
        'w_in_a': nrm((N_A_LAYERS, D, 3 * CONV_DIM + MEM_DIM), D ** -0.5),
        'conv_w': nrm((N_A_LAYERS, CONV_WIDTH, CONV_DIM), CONV_WIDTH ** -0.5),
        'w_out_a': nrm((N_A_LAYERS, CONV_DIM + MEM_DIM, D), (CONV_DIM + MEM_DIM) ** -0.5),
        'kv_norm': gain((D,)),
        'w_kv': nrm((D, 2 * N_KV_HEADS * HEAD_DIM), D ** -0.5),
        'w_in_b': nrm((N_B_LAYERS, D, ATTN_DIM + MEM_DIM), D ** -0.5),
        'attn_sinks': nrm((N_B_LAYERS, N_HEADS), 1.0),
        'rel_bias': nrm((REL_BUCKETS, N_HEADS), 0.5),
        'w_out_b': nrm((N_B_LAYERS, ATTN_DIM + MEM_DIM, D), (ATTN_DIM + MEM_DIM) ** -0.5),
        'mem_norm': gain((DEPTH, D)),
        'w_mem_kv': nrm((DEPTH, D, 2 * MEM_DIM), D ** -0.5),
        'ffn2_norm': gain((DEPTH, D)),
        'ffn2_wg': nrm((DEPTH, D, FFN_DIM), D ** -0.5),
        'ffn2_wu': nrm((DEPTH, D, FFN_DIM), D ** -0.5),
        'ffn2_wd': nrm((DEPTH, FFN_DIM, D), FFN_DIM ** -0.5),
        'final_norm': gain((D,)),
    }


def reference(x_prompt, x_sample, state_conv, cache_swa_k, cache_swa_v, cache_mem_k, cache_mem_v,
              mem_prompt, ffn1_norm, ffn1_wg, ffn1_wu, ffn1_wd, mix_norm, w_in_a, conv_w, w_out_a,
              kv_norm, w_kv, w_in_b, attn_sinks, rel_bias, w_out_b, mem_norm, w_mem_kv,
              ffn2_norm, ffn2_wg, ffn2_wu, ffn2_wd, final_norm):
    W = dict(ffn1_norm=ffn1_norm, ffn1_wg=ffn1_wg, ffn1_wu=ffn1_wu, ffn1_wd=ffn1_wd,
             mix_norm=mix_norm, w_in_a=w_in_a, conv_w=conv_w, w_out_a=w_out_a,
             kv_norm=kv_norm, w_kv=w_kv, w_in_b=w_in_b, attn_sinks=attn_sinks,
             rel_bias=rel_bias, w_out_b=w_out_b,
             ffn2_norm=ffn2_norm, ffn2_wg=ffn2_wg, ffn2_wu=ffn2_wu, ffn2_wd=ffn2_wd,
             final_norm=final_norm)
    mk_list, mv_list = [], []
    for l in range(DEPTH):
        mk, mv = memory_kv(mem_prompt, mem_norm[l], w_mem_kv[l])
        mk_list.append(mk)
        mv_list.append(mv)
    mem_k_prompt = jnp.stack(mk_list)
    mem_v_prompt = jnp.stack(mv_list)
    conv_zero = jnp.zeros((N_A_LAYERS, x_prompt.shape[0], CONV_WIDTH - 1, CONV_DIM), x_prompt.dtype)
    y_prompt, conv_state_prompt, swa_k_prompt, swa_v_prompt = trunk(
        x_prompt, conv_zero, None, None, mem_k_prompt, mem_v_prompt, W)
    y_sample, conv_state_sample, swa_k_sample, swa_v_sample = trunk(
        x_sample, state_conv, cache_swa_k, cache_swa_v, cache_mem_k, cache_mem_v, W)
    return (y_prompt, y_sample, conv_state_prompt, conv_state_sample,
            swa_k_prompt, swa_v_prompt, swa_k_sample, swa_v_sample,
            mem_k_prompt, mem_v_prompt)
```

```cpp
#include <hip/hip_runtime.h>
#include <hip/hip_cooperative_groups.h>
#include <cstdio>
namespace cg = cooperative_groups;

#ifndef ONE_LAUNCH
#define ONE_LAUNCH 1
#endif
#ifndef DUP_BAR
#define DUP_BAR 0
#endif
#ifndef DUP_MASK
#define DUP_MASK 0
#endif

#define LAS __attribute__((address_space(3)))
#define DI __device__ __forceinline__
typedef unsigned short u16;
typedef short bf16x8 __attribute__((ext_vector_type(8)));
typedef short s16x4 __attribute__((ext_vector_type(4)));
typedef float f32x4 __attribute__((ext_vector_type(4)));
typedef float f32x16 __attribute__((ext_vector_type(16)));
typedef unsigned u32x4 __attribute__((ext_vector_type(4)));
typedef unsigned u32x2 __attribute__((ext_vector_type(2)));

constexpr int D = 1024, FF = 2816, MP = 16384, MS = 1024, MT = MP + MS, SEQ = 8192;
constexpr int NTHR = 512, STAGE_BYTES = 131072, LDS_BYTES = STAGE_BYTES + 16;
constexpr int NPHASE = 41;
constexpr int NSPLIT = 4;

constexpr size_t O_Y = 0;
constexpr size_t O_CSP = (size_t)MT * D;
constexpr size_t O_CSS = O_CSP + 8192;
constexpr size_t O_SKP = O_CSS + 524288;
constexpr size_t O_SVP = O_SKP + 65536;
constexpr size_t O_SKS = O_SVP + 65536;
constexpr size_t O_SVS = O_SKS + 4194304;
constexpr size_t O_MKP = O_SVS + 4194304;
constexpr size_t O_MVP = O_MKP + 1048576;

constexpr size_t WS_X = 0;
constexpr size_t WS_XN = WS_X + (size_t)MT * D * 4;
constexpr size_t WS_XN2 = WS_XN + (size_t)MT * D * 2;
constexpr size_t WS_H = WS_XN2 + (size_t)MT * D * 2;
constexpr size_t WS_Z = WS_H + (size_t)MT * FF * 2;
constexpr size_t WS_Y = WS_Z + (size_t)MT * 3584 * 2;
constexpr size_t WS_KVB = WS_Y + (size_t)MT * 1536 * 2;
constexpr size_t WS_MEMN = WS_KVB + (size_t)MT * 512 * 2;
constexpr size_t WS_MEMKV = WS_MEMN + (size_t)4 * 512 * 1024 * 2;
constexpr size_t WS_W = WS_MEMKV + (size_t)4 * 512 * 1024 * 2;
constexpr size_t SZ_WGU = (size_t)5632 * 1024 * 2, SZ_WD = (size_t)1024 * 2816 * 2, SZ_WINA = (size_t)3584 * 1024 * 2, SZ_WINB = (size_t)1536 * 1024 * 2,
                 SZ_WOUT = (size_t)1024 * 1536 * 2, SZ_WKV = (size_t)512 * 1024 * 2, SZ_WMEM = (size_t)1024 * 1024 * 2;
constexpr size_t WS_WGU1 = WS_W, WS_WD1 = WS_WGU1 + 4 * SZ_WGU, WS_WGU2 = WS_WD1 + 4 * SZ_WD, WS_WD2 = WS_WGU2 + 4 * SZ_WGU, WS_WMEM = WS_WD2 + 4 * SZ_WD,
                 WS_WINA = WS_WMEM + 4 * SZ_WMEM, WS_WOUTA = WS_WINA + 2 * SZ_WINA, WS_WINB = WS_WOUTA + 2 * SZ_WOUT, WS_WOUTB = WS_WINB + 2 * SZ_WINB,
                 WS_WKV = WS_WOUTB + 2 * SZ_WOUT, WS_BAR = WS_WKV + SZ_WKV, WS_SSP = WS_BAR + 16384, WS_SSQ = WS_SSP + (size_t)13 * MT * 4, WS_P = WS_SSQ + (size_t)MT * 16 * 4,
                 WS_END = WS_P + (size_t)NSPLIT * MS * D * 4;

struct Params {
    const float* in[29];
    float* out;
    unsigned char* ws;
    int ph_lo, ph_hi;
};

DI unsigned cvt_pk_bf16(float lo, float hi) { unsigned r; asm("v_cvt_pk_bf16_f32 %0, %1, %2" : "=v"(r) : "v"(lo), "v"(hi)); return r; }
DI float bf_lo(unsigned w) { return __uint_as_float(w << 16); }
DI float bf_hi(unsigned w) { return __uint_as_float(w & 0xffff0000u); }
DI float wave_sum(float v) {
#pragma unroll
    for (int o = 32; o >= 1; o >>= 1) v += __shfl_xor(v, o);
    return v;
}
DI int opaque_tid() { int t = threadIdx.x; asm volatile("" : "+v"(t)); return t; }
DI u32x4 pack8(f32x4 a, f32x4 b) { u32x4 w; w.x = cvt_pk_bf16(a[0], a[1]); w.y = cvt_pk_bf16(a[2], a[3]); w.z = cvt_pk_bf16(b[0], b[1]); w.w = cvt_pk_bf16(b[2], b[3]); return w; }
DI float silu_f(float x) { return x * __builtin_amdgcn_rcpf(1.0f + __expf(-x)); }

#define XB_TMO      128
#define XB_XCNT(j)  (256  + 64 * (j))
#define XB_XSUB(j)  (1280 + 64 * (j))
#define XB_XGEN(j)  (2304 + 64 * (j))
#define XB_TOP      3328
#define XB_TOPGEN   3392
#define XCD_BAR_WORDS 3456
#define XB_SPIN_CAP (1u << 22)
DI unsigned xb_ld(unsigned* p)              { return __hip_atomic_load(p, __ATOMIC_RELAXED, __HIP_MEMORY_SCOPE_AGENT); }
DI unsigned xb_add(unsigned* p, unsigned v) { return __hip_atomic_fetch_add(p, v, __ATOMIC_RELAXED, __HIP_MEMORY_SCOPE_AGENT); }
DI unsigned xb_xcc_id() { return (unsigned)__builtin_amdgcn_s_getreg((3 << 11) | 20) & 0xFu; }
#define XB_SPIN(cond, bar) do { unsigned _sp = 0; while (cond) { __builtin_amdgcn_s_sleep(1); \
    if ((++_sp & 255u) == 0u) { if (xb_ld(&(bar)[XB_TMO])) break; if (_sp > XB_SPIN_CAP) { atomicAdd(&(bar)[XB_TMO], 1u); break; } } } } while (0)
struct XcdBarrier { unsigned* bar; unsigned x; volatile LAS unsigned* st; };
DI XcdBarrier xcd_barrier_post(unsigned* bar, volatile LAS unsigned* st) {
    XcdBarrier b; b.bar = bar; b.x = xb_xcc_id(); b.st = st;
    if (threadIdx.x == 0) (void)xb_add(&bar[XB_XCNT(b.x)], 1u);
    return b;
}
DI void xcd_barrier_complete(unsigned* bar, unsigned x, unsigned& nloc, unsigned& nx) {
    const unsigned G = gridDim.x * gridDim.y * gridDim.z;
    unsigned sum, cnt, mine, sp = 0u;
    for (;;) {
        sum = 0u; cnt = 0u; mine = 0u;
#pragma unroll
        for (unsigned j = 0; j < 16; ++j) { const unsigned c = xb_ld(&bar[XB_XCNT(j)]); sum += c; cnt += (c > 0u) ? 1u : 0u; mine = (j == x) ? c : mine; }
        if (sum == G) break;
        __builtin_amdgcn_s_sleep(1);
        if ((++sp & 255u) == 0u) { if (xb_ld(&bar[XB_TMO])) break; if (sp > XB_SPIN_CAP) { atomicAdd(&bar[XB_TMO], 1u); break; } }
    }
    nloc = mine > 0u ? mine : 1u; nx = cnt > 0u ? cnt : 1u;
}
DI void xcd_barrier(const XcdBarrier& b) {
    asm volatile("s_waitcnt vmcnt(0)" ::: "memory");
    __syncthreads();
    if (threadIdx.x == 0) {
        unsigned* bar = b.bar;
        __builtin_amdgcn_s_waitcnt(0);
        unsigned nloc = b.st[0], nx = b.st[1];
        if (nloc == 0u) { xcd_barrier_complete(bar, b.x, nloc, nx); b.st[0] = nloc; b.st[1] = nx; }
        const unsigned old = xb_add(&bar[XB_XSUB(b.x)], 1u);
        const unsigned gen = old / nloc;
        if (old + 1u == (gen + 1u) * nloc) {
            __builtin_amdgcn_fence(__ATOMIC_RELEASE, "agent");
            asm volatile("s_waitcnt vmcnt(0)" ::: "memory");
            const unsigned og = xb_add(&bar[XB_TOP], 1u);
            const unsigned tg = og / nx;
            if (og + 1u == (tg + 1u) * nx) xb_add(&bar[XB_TOPGEN], 1u);
            else XB_SPIN(xb_ld(&bar[XB_TOPGEN]) == tg, bar);
            __builtin_amdgcn_fence(__ATOMIC_ACQUIRE, "agent");
            xb_add(&bar[XB_XGEN(b.x)], 1u);
            asm volatile("s_waitcnt vmcnt(0)" ::: "memory");
        } else {
            XB_SPIN(xb_ld(&bar[XB_XGEN(b.x)]) == gen, bar);
            __builtin_amdgcn_fence(__ATOMIC_ACQUIRE, "agent");
            asm volatile("s_waitcnt vmcnt(0)" ::: "memory");
        }
    }
    __syncthreads();
}

namespace pg8 {
constexpr int BM = 256, BK = 64, HALF = 128, HTB = HALF * BK * 2, NXCD = 8, WGM = 4;
DI int lds_byte(int r, int c) { const int st = (r >> 4) * 2 + (c >> 5), rr = r & 15, cc = c & 31, ob = rr * 64 + cc * 2; return st * 1024 + (ob ^ (((ob >> 9) & 1) << 5)); }
DI void stage_rc(int b, int& R, int& C) { const int st = b / 1024, sb = b % 1024, swz = sb ^ (((sb >> 9) & 1) << 5); R = (st >> 1) * 16 + swz / 64; C = (st & 1) * 32 + (swz % 64) / 2; }
DI int perm32(int rho) { const int n = rho >> 4, i = rho & 15; return 8 * (i >> 2) + 4 * n + (i & 3); }
struct Unit { int pm, pn, k0, nt, part; };
struct Gemm { const u16* A; const u16* Bt; int M, N, K; };
struct StaticOrder {
    int nM, nN, nwg, G, c, ntk, ns, nMall;
    DI void init(int M, int N, int K, int G_, int c_, int ns_) { nMall = M / BM; nM = ns_ ? MP / BM : nMall; nN = N / BM; nwg = nM * nN; G = G_; c = c_; ntk = K / BK; ns = ns_; }
    DI Unit next(int i) const {
        Unit u; u.pm = 0; u.pn = 0; u.k0 = 0; u.nt = 0; u.part = -1;
        const long L = (long)i * G + c; if (c < 0) return u;
        if (L >= nwg) {
            if (ns == 0) return u;
            const int j = (int)(L - nwg); if (j >= (nMall - nM) * nN * ns) return u;
            const int tile = j / ns, sp = j % ns, pairs = ntk >> 1, base = pairs / ns, rem = pairs % ns;
            u.pm = nM + tile / nN; u.pn = tile % nN; u.part = sp;
            u.k0 = 2 * (sp * base + (sp < rem ? sp : rem)); u.nt = 2 * (base + (sp < rem ? 1 : 0));
            return u;
        }
        int wgid = (int)L; { const int q = nwg / NXCD, r = nwg % NXCD, xcd = wgid % NXCD, off = wgid / NXCD; wgid = (xcd < r ? xcd * (q + 1) : r * (q + 1) + (xcd - r) * q) + off; }
        const int nig = WGM * nN, gid = wgid / nig, fm = gid * WGM, gsz = (nM - fm) < WGM ? (nM - fm) : WGM;
        u.pm = fm + ((wgid % nig) % gsz); u.pn = (wgid % nig) / gsz; u.nt = ntk; return u;
    }
};

template <class Epi>
DI void gemm_phase(LAS unsigned char* lds, const Gemm g, const StaticOrder& S, const Epi& E) {
    const int tid = opaque_tid(), wid = __builtin_amdgcn_readfirstlane(tid >> 6), lane = tid & 63, wr = wid >> 2, wc = wid & 3, fr = lane & 15, fq = lane >> 4;
    const int K = g.K;
    unsigned voffA[2], voffB[2];
#pragma unroll
    for (int i = 0; i < 2; ++i) { int R, C; stage_rc(tid * 16 + i * 8192, R, C); const int Rb = Epi::PERM ? ((R & ~31) + perm32(R & 31)) : R;
        voffA[i] = (unsigned)(R * K + C) * 2u; voffB[i] = (unsigned)(Rb * K + C) * 2u; }
    const size_t kstep = (size_t)(BK * 2);
    const size_t hstep = (size_t)HALF * K * 2;
    const size_t tstep = 2 * hstep;
    const unsigned ldsw = (unsigned)wid * 1024u;
    const int aoff = lds_byte(wr * 64 + fr, fq * 8), boff = lds_byte(wc * 32 + fr, fq * 8);
#define PG8_SA(b, h) (((b) * 2 + (h)) * HTB)
#define PG8_SB(b, h) ((4 + (b) * 2 + (h)) * HTB)
#define PG8_STAGE(bufoff, gbase, voff) do { _Pragma("unroll") for (int _i = 0; _i < 2; ++_i) \
        __builtin_amdgcn_global_load_lds((const unsigned*)((const char*)(gbase) + (voff)[_i]), (LAS unsigned*)(lds + (bufoff) + ldsw + _i * 8192), 16, 0, 0); } while (0)
#define PG8_LDA(dst, b, h) do { _Pragma("unroll") for (int m = 0; m < 4; ++m) _Pragma("unroll") for (int k = 0; k < 2; ++k) dst[m][k] = *(const LAS bf16x8*)(lds + PG8_SA(b, h) + aoff + m * 2048 + k * 1024); } while (0)
#define PG8_LDB(dst, b, h) do { _Pragma("unroll") for (int n = 0; n < 2; ++n) _Pragma("unroll") for (int k = 0; k < 2; ++k) dst[n][k] = *(const LAS bf16x8*)(lds + PG8_SB(b, h) + boff + n * 2048 + k * 1024); } while (0)
#define PG8_MMA(ai, bj, At, Bt) do { __builtin_amdgcn_s_setprio(1); _Pragma("unroll") for (int m = 0; m < 4; ++m) _Pragma("unroll") for (int n = 0; n < 2; ++n) _Pragma("unroll") for (int k = 0; k < 2; ++k) \
        acc[ai][bj][m][n] = __builtin_amdgcn_mfma_f32_16x16x32_bf16(Bt[n][k], At[m][k], acc[ai][bj][m][n], 0, 0, 0); __builtin_amdgcn_s_setprio(0); } while (0)
#define PG8_WAIT_V(n) asm volatile("s_waitcnt vmcnt(" #n ")" ::: "memory")
#define PG8_WAIT_L(n) asm volatile("s_waitcnt lgkmcnt(" #n ")" ::: "memory")
#define PG8_BAR __builtin_amdgcn_s_barrier()
#define PG8_SCHED __builtin_amdgcn_sched_barrier(0)
    Unit cur = S.next(0), nxt; int ui = 0;
    if (cur.nt == 0) return;
    f32x4 acc[2][2][4][2];
#pragma unroll
    for (int a = 0; a < 2; ++a)
#pragma unroll
        for (int b = 0; b < 2; ++b)
#pragma unroll
            for (int m = 0; m < 4; ++m)
#pragma unroll
                for (int n = 0; n < 2; ++n) acc[a][b][m][n] = (f32x4){0.f, 0.f, 0.f, 0.f};
    bf16x8 At[4][2], B0[2][2], B1[2][2];
    const char* cA = (const char*)g.A + (size_t)cur.pm * tstep + (size_t)cur.k0 * kstep; const char* cB = (const char*)g.Bt + (size_t)cur.pn * tstep + (size_t)cur.k0 * kstep;
    float rsum[8];
#pragma unroll
    for (int k = 0; k < 8; ++k) rsum[k] = 0.f;
    E.load_rs(cur, wr, fr, rsum);
    PG8_STAGE(PG8_SB(0, 0), cB, voffB); PG8_STAGE(PG8_SB(0, 1), cB + hstep, voffB); PG8_STAGE(PG8_SA(0, 0), cA, voffA); PG8_STAGE(PG8_SA(0, 1), cA + hstep, voffA);
    if (wr == 1) PG8_BAR;
    PG8_WAIT_V(2); PG8_BAR;
    PG8_STAGE(PG8_SB(1, 0), cB + kstep, voffB); PG8_STAGE(PG8_SA(1, 0), cA + kstep, voffA); PG8_STAGE(PG8_SB(1, 1), cB + hstep + kstep, voffB);
    PG8_WAIT_V(6); PG8_BAR;
    for (;;) {
        nxt = S.next(ui + 1);
        const bool has_next = nxt.nt != 0;
        const char* nA = has_next ? (const char*)g.A + (size_t)nxt.pm * tstep + (size_t)nxt.k0 * kstep : cA; const char* nB = has_next ? (const char*)g.Bt + (size_t)nxt.pn * tstep + (size_t)nxt.k0 * kstep : cB;
        const int nt = cur.nt;
        for (int t = 0; t < nt; t += 2) {
            const bool last = (t == nt - 2);
            const char* a1 = cA + (size_t)(t + 1) * kstep;
            const char* a2 = last ? nA : cA + (size_t)(t + 2) * kstep; const char* b2 = last ? nB : cB + (size_t)(t + 2) * kstep;
            const char* a3 = a2 + kstep; const char* b3 = b2 + kstep;
            PG8_LDB(B0, 0, 0); PG8_LDB(B1, 0, 1); PG8_SCHED; PG8_LDA(At, 0, 0); PG8_STAGE(PG8_SA(1, 1), a1 + hstep, voffA);
            PG8_WAIT_V(8); PG8_WAIT_L(0); PG8_BAR; PG8_MMA(0, 0, At, B0); PG8_MMA(0, 1, At, B1); PG8_BAR; PG8_SCHED;
            PG8_LDA(At, 0, 1); PG8_STAGE(PG8_SB(0, 0), b2, voffB); PG8_STAGE(PG8_SB(0, 1), b2 + hstep, voffB); PG8_STAGE(PG8_SA(0, 0), a2, voffA);
            PG8_WAIT_V(8); PG8_WAIT_L(0); PG8_BAR; PG8_MMA(1, 0, At, B0); PG8_MMA(1, 1, At, B1); PG8_BAR; PG8_SCHED;
            PG8_LDB(B0, 1, 0); PG8_LDB(B1, 1, 1); PG8_SCHED; PG8_LDA(At, 1, 0); PG8_STAGE(PG8_SA(0, 1), a2 + hstep, voffA);
            PG8_WAIT_V(8); PG8_WAIT_L(0); PG8_BAR; PG8_MMA(0, 0, At, B0); PG8_MMA(0, 1, At, B1); PG8_BAR; PG8_SCHED;
            PG8_LDA(At, 1, 1); PG8_STAGE(PG8_SB(1, 0), b3, voffB); PG8_STAGE(PG8_SB(1, 1), b3 + hstep, voffB); PG8_STAGE(PG8_SA(1, 0), a3, voffA);
            PG8_WAIT_V(8); PG8_WAIT_L(0); PG8_BAR; PG8_MMA(1, 0, At, B0); PG8_MMA(1, 1, At, B1); PG8_BAR; PG8_SCHED;
        }
        if (wr == 0) PG8_BAR;
        E(acc, cur, wr, wc, fr, fq, rsum);
        if (!has_next) break;
        E.load_rs(nxt, wr, fr, rsum);
#pragma unroll
        for (int a = 0; a < 2; ++a)
#pragma unroll
            for (int b = 0; b < 2; ++b)
#pragma unroll
                for (int m = 0; m < 4; ++m)
#pragma unroll
                    for (int n = 0; n < 2; ++n) acc[a][b][m][n] = (f32x4){0.f, 0.f, 0.f, 0.f};
        cur = nxt; cA = nA; cB = nB; ++ui;
        if (wr == 1) PG8_BAR;
    }
    PG8_WAIT_V(0);
    PG8_BAR;
#undef PG8_SA
#undef PG8_SB
#undef PG8_STAGE
#undef PG8_LDA
#undef PG8_LDB
#undef PG8_MMA
#undef PG8_WAIT_V
#undef PG8_WAIT_L
#undef PG8_BAR
#undef PG8_SCHED
}
}
using pg8::Unit;

enum { EM_SWIGLU = 0, EM_RESID = 1, EM_BF16 = 2, EM_KV = 3, EM_MEMKV = 4 };
struct Epi {
    static constexpr bool PERM = true;
    int mode; u16* O; int ldc; float* F0; float* F1; float s;
    float* SSP;
    DI void load_rs(const Unit& u, int wr, int fr, float (&rsum)[8]) const {
        if (SSP && mode != EM_RESID) {
#pragma unroll
            for (int k = 0; k < 8; ++k) rsum[k] = SSP[u.pm * 256 + (k >> 2) * 128 + wr * 64 + (k & 3) * 16 + fr];
        }
    }
    DI float row_rs(float t) const { return SSP ? rsqrtf(t * (1.0f / D) + 1e-5f) : 1.0f; }
    DI void operator()(const f32x4 (&acc)[2][2][4][2], const Unit& u, int wr, int wc, int fr, int fq, const float (&rsum)[8]) const {
        const int row0 = u.pm * 256 + wr * 64 + fr, cin = wc * 32 + 8 * fq;
        if (mode == EM_SWIGLU) {
#pragma unroll
            for (int ai = 0; ai < 2; ++ai)
#pragma unroll
                for (int m = 0; m < 4; ++m) {
                    u16* rowp = O + (size_t)(row0 + ai * 128 + m * 16) * FF + u.pn * 128 + cin;
                    const float rs = row_rs(rsum[ai * 4 + m]);
                    const f32x4 g0 = acc[ai][0][m][0] * rs, g1 = acc[ai][0][m][1] * rs, u0 = acc[ai][1][m][0] * rs, u1 = acc[ai][1][m][1] * rs;
                    u32x4 w;
                    w.x = cvt_pk_bf16(silu_f(g0[0]) * u0[0], silu_f(g0[1]) * u0[1]); w.y = cvt_pk_bf16(silu_f(g0[2]) * u0[2], silu_f(g0[3]) * u0[3]);
                    w.z = cvt_pk_bf16(silu_f(g1[0]) * u1[0], silu_f(g1[1]) * u1[1]); w.w = cvt_pk_bf16(silu_f(g1[2]) * u1[2], silu_f(g1[3]) * u1[3]);
                    *(u32x4*)rowp = w;
                }
        } else if (mode == EM_RESID && u.part >= 0) {
#pragma unroll
            for (int ai = 0; ai < 2; ++ai)
#pragma unroll
                for (int m = 0; m < 4; ++m) {
                    float* rowp = F1 + ((size_t)u.part * MS + (row0 + ai * 128 + m * 16 - MP)) * D + u.pn * 256 + cin;
#pragma unroll
                    for (int bj = 0; bj < 2; ++bj) { f32x4* p0 = (f32x4*)(rowp + bj * 128); p0[0] = acc[ai][bj][m][0] * s; p0[1] = acc[ai][bj][m][1] * s; }
                }
        } else if (mode == EM_RESID) {
#pragma unroll
            for (int ai = 0; ai < 2; ++ai)
#pragma unroll
                for (int m = 0; m < 4; ++m) {
                    const int row = row0 + ai * 128 + m * 16;
                    u16* rowp = O + (size_t)row * D + u.pn * 256 + cin;
                    float ssq = 0.f;
#pragma unroll
                    for (int bj = 0; bj < 2; ++bj) {
                        const u32x4 xb = *(const u32x4*)(rowp + bj * 128);
                        const f32x4 x0 = (f32x4){bf_lo(xb.x), bf_hi(xb.x), bf_lo(xb.y), bf_hi(xb.y)} + acc[ai][bj][m][0] * s;
                        const f32x4 x1 = (f32x4){bf_lo(xb.z), bf_hi(xb.z), bf_lo(xb.w), bf_hi(xb.w)} + acc[ai][bj][m][1] * s;
                        *(u32x4*)(rowp + bj * 128) = pack8(x0, x1);
                        ssq += (x0[0] * x0[0] + x0[1] * x0[1]) + (x0[2] * x0[2] + x0[3] * x0[3]) + (x1[0] * x1[0] + x1[1] * x1[1]) + (x1[2] * x1[2] + x1[3] * x1[3]);
                    }
                    ssq += __shfl_xor(ssq, 16); ssq += __shfl_xor(ssq, 32);
                    if (fq == 0 && SSP) SSP[(size_t)row * 16 + u.pn * 4 + wc] = ssq;
                }
        } else {
#pragma unroll
            for (int ai = 0; ai < 2; ++ai)
#pragma unroll
                for (int m = 0; m < 4; ++m) {
                    const int r = row0 + ai * 128 + m * 16, col0 = u.pn * 256 + cin;
                    u16* rowp = O + (size_t)r * ldc + col0;
                    float* fo = nullptr;
                    if (mode == EM_KV) {
                        if (r < MP) { const int b = r >> 13, t = r & 8191; if (t >= SEQ - 128) fo = F0 + (u.pn ? O_SVP : O_SKP) + (size_t)(b * 128 + (t - (SEQ - 128))) * 256 + cin; }
                        else { const int rs = r - MP, b = rs >> 3, t = rs & 7; fo = F0 + (u.pn ? O_SVS : O_SKS) + (size_t)(b * 128 + 120 + t) * 256 + cin; }
                    } else if (mode == EM_MEMKV) {
                        fo = (col0 < 512 ? F0 + (size_t)r * 512 + col0 : F1 + (size_t)r * 512 + (col0 - 512));
                    }
                    const float rs = row_rs(rsum[ai * 4 + m]);
#pragma unroll
                    for (int bj = 0; bj < 2; ++bj) {
                        const f32x4 v0 = acc[ai][bj][m][0] * rs, v1 = acc[ai][bj][m][1] * rs;
                        u32x4 w; w.x = cvt_pk_bf16(v0[0], v0[1]); w.y = cvt_pk_bf16(v0[2], v0[3]); w.z = cvt_pk_bf16(v1[0], v1[1]); w.w = cvt_pk_bf16(v1[2], v1[3]);
                        *(u32x4*)(rowp + bj * 128) = w;
                        if (fo) { *(f32x4*)(fo + bj * 128) = v0; *(f32x4*)(fo + bj * 128 + 4) = v1; }
                    }
                }
        }
    }
};

DI void wt_tile(const float* __restrict__ src, u16* __restrict__ dst, int K, int N, int mode, int tile, LAS unsigned* T, const float* __restrict__ gain) {
    const int tid = opaque_tid();
    const int nN = N >> 6, nt = tile % nN, kt = tile / nN, k0 = kt * 128, n0 = nt * 64;
    const int drow0 = (mode == 0) ? n0 : ((n0 >> 7) * 256 + (n0 & 127) + (mode == 2 ? 128 : 0));
#pragma unroll
    for (int pass = 0; pass < 2; ++pass) {
        const int kp = pass * 32 + (tid >> 4), nl = (tid & 15) * 4;
        const float* s = src + (size_t)(k0 + 2 * kp) * N + n0 + nl;
        const float ga = gain ? gain[k0 + 2 * kp] : 1.0f, gb = gain ? gain[k0 + 2 * kp + 1] : 1.0f;
        const f32x4 a = *(const f32x4*)s * ga, b = *(const f32x4*)(s + N) * gb;
        T[(nl + 0) * 65 + kp] = cvt_pk_bf16(a[0], b[0]); T[(nl + 1) * 65 + kp] = cvt_pk_bf16(a[1], b[1]);
        T[(nl + 2) * 65 + kp] = cvt_pk_bf16(a[2], b[2]); T[(nl + 3) * 65 + kp] = cvt_pk_bf16(a[3], b[3]);
    }
    __syncthreads();
    {
        const int n = tid >> 3, c = tid & 7;
        u32x4 w0, w1;
        w0.x = T[n * 65 + c * 8 + 0]; w0.y = T[n * 65 + c * 8 + 1]; w0.z = T[n * 65 + c * 8 + 2]; w0.w = T[n * 65 + c * 8 + 3];
        w1.x = T[n * 65 + c * 8 + 4]; w1.y = T[n * 65 + c * 8 + 5]; w1.z = T[n * 65 + c * 8 + 6]; w1.w = T[n * 65 + c * 8 + 7];
        u16* d = dst + (size_t)(drow0 + n) * K + k0 + c * 16;
        *(u32x4*)d = w0; *(u32x4*)(d + 8) = w1;
    }
    __syncthreads();
}
constexpr int WT_TILES = 11072;
DI void wt_dispatch(const Params& p, int idx, LAS unsigned* T) {
    const float* src; u16* dst; int K, N, mode = 0, tile; const float* gain = nullptr;
    unsigned char* ws = p.ws;
    if (idx < 8960) {
        const int l = idx / 2240, r = idx % 2240; int t = r / 352; if (t > 6) t = 6; tile = r - t * 352;
        if (t == 0) { src = p.in[9] + (size_t)l * D * FF; dst = (u16*)(ws + WS_WGU1 + l * SZ_WGU); K = D; N = FF; mode = 1; gain = p.in[8] + l * D; }
        else if (t == 1) { src = p.in[10] + (size_t)l * D * FF; dst = (u16*)(ws + WS_WGU1 + l * SZ_WGU); K = D; N = FF; mode = 2; gain = p.in[8] + l * D; }
        else if (t == 2) { src = p.in[11] + (size_t)l * D * FF; dst = (u16*)(ws + WS_WD1 + l * SZ_WD); K = FF; N = D; }
        else if (t == 3) { src = p.in[25] + (size_t)l * D * FF; dst = (u16*)(ws + WS_WGU2 + l * SZ_WGU); K = D; N = FF; mode = 1; gain = p.in[24] + l * D; }
        else if (t == 4) { src = p.in[26] + (size_t)l * D * FF; dst = (u16*)(ws + WS_WGU2 + l * SZ_WGU); K = D; N = FF; mode = 2; gain = p.in[24] + l * D; }
        else if (t == 5) { src = p.in[27] + (size_t)l * D * FF; dst = (u16*)(ws + WS_WD2 + l * SZ_WD); K = FF; N = D; }
        else { src = p.in[23] + (size_t)l * D * 1024; dst = (u16*)(ws + WS_WMEM + l * SZ_WMEM); K = D; N = 1024; }
    } else {
        int r = idx - 8960;
        if (r < 896) { const int j = r / 448; tile = r % 448; src = p.in[13] + (size_t)j * D * 3584; dst = (u16*)(ws + WS_WINA + j * SZ_WINA); K = D; N = 3584; gain = p.in[12] + j * D; }
        else if (r < 1280) { r -= 896; const int j = r / 192; tile = r % 192; src = p.in[15] + (size_t)j * 1536 * D; dst = (u16*)(ws + WS_WOUTA + j * SZ_WOUT); K = 1536; N = D; }
        else if (r < 1664) { r -= 1280; const int j = r / 192; tile = r % 192; src = p.in[18] + (size_t)j * D * 1536; dst = (u16*)(ws + WS_WINB + j * SZ_WINB); K = D; N = 1536; gain = p.in[12] + (2 + j) * D; }
        else if (r < 2048) { r -= 1664; const int j = r / 192; tile = r % 192; src = p.in[21] + (size_t)j * 1536 * D; dst = (u16*)(ws + WS_WOUTB + j * SZ_WOUT); K = 1536; N = D; }
        else { tile = r - 2048; src = p.in[17]; dst = (u16*)(ws + WS_WKV); K = D; N = 512; gain = p.in[16]; }
    }
    wt_tile(src, dst, K, N, mode, tile, T, gain);
}

DI void wt_deferred(const Params& p, int l, int s, LAS unsigned* T) {
    const int id = (int)blockIdx.x - 64, n = (int)gridDim.x - 64;
    if (id < 0 || n <= 0) return;
    int lo0 = 0, hi0 = 0, lo1 = 0, hi1 = 0, lo2 = 0, hi2 = 0;
    if (s == 1) {
        if (l < 2) { lo0 = 8960 + l * 448; hi0 = lo0 + 448; lo1 = 9856 + l * 192; hi1 = lo1 + 192; }
        else { lo0 = 10240 + (l - 2) * 192; hi0 = lo0 + 192; lo1 = 10624 + (l - 2) * 192; hi1 = lo1 + 192; }
        lo2 = l * 2240 + 1760; hi2 = lo2 + 352;
    } else if (s == 5) { lo0 = l * 2240 + 1056; hi0 = lo0 + 704; }
    else if (l < 3) { lo0 = (l + 1) * 2240; hi0 = lo0 + 1056; if (l == 1) { lo1 = 11008; hi1 = 11072; } }
    for (int idx = lo0 + id; idx < hi0; idx += n) wt_dispatch(p, idx, T);
    for (int idx = lo1 + id; idx < hi1; idx += n) wt_dispatch(p, idx, T);
    for (int idx = lo2 + id; idx < hi2; idx += n) wt_dispatch(p, idx, T);
}

DI void norm_phase(const u16* srcH, const float* srcA, int rowsA, const float* srcB, int nrows, const float* g1, u16* d1, const float* g2, u16* d2, float* ssout, float* fout) {
    const int tid = opaque_tid(), lane = tid & 63, wid = tid >> 6;
    for (int row = blockIdx.x * 8 + wid; row < nrows; row += gridDim.x * 8) {
        f32x4 v[4]; float ss = 0.f;
        if (srcH) {
#pragma unroll
            for (int i = 0; i < 4; ++i) { const u32x2 xb = *(const u32x2*)(srcH + (size_t)row * D + i * 256 + lane * 4); v[i] = (f32x4){bf_lo(xb.x), bf_hi(xb.x), bf_lo(xb.y), bf_hi(xb.y)}; }
        } else {
            const float* s = row < rowsA ? srcA + (size_t)row * D : srcB + (size_t)(row - rowsA) * D;
#pragma unroll
            for (int i = 0; i < 4; ++i) v[i] = *(const f32x4*)(s + i * 256 + lane * 4);
        }
#pragma unroll
        for (int i = 0; i < 4; ++i) ss += v[i][0] * v[i][0] + v[i][1] * v[i][1] + v[i][2] * v[i][2] + v[i][3] * v[i][3];
        ss = wave_sum(ss);
        const float r = rsqrtf(ss * (1.0f / D) + 1e-5f);
        if (ssout) {
            if (lane == 0) ssout[row] = ss;
#pragma unroll
            for (int i = 0; i < 4; ++i) { u32x2 w; w.x = cvt_pk_bf16(v[i][0], v[i][1]); w.y = cvt_pk_bf16(v[i][2], v[i][3]); *(u32x2*)(d1 + (size_t)row * D + i * 256 + lane * 4) = w; }
            continue;
        }
        if (d1) {
#pragma unroll
            for (int i = 0; i < 4; ++i) { const f32x4 g = *(const f32x4*)(g1 + i * 256 + lane * 4); u32x2 w; w.x = cvt_pk_bf16(v[i][0] * r * g[0], v[i][1] * r * g[1]); w.y = cvt_pk_bf16(v[i][2] * r * g[2], v[i][3] * r * g[3]);
                *(u32x2*)(d1 + (size_t)row * D + i * 256 + lane * 4) = w; }
        }
        if (d2) {
#pragma unroll
            for (int i = 0; i < 4; ++i) { const f32x4 g = *(const f32x4*)(g2 + i * 256 + lane * 4); u32x2 w; w.x = cvt_pk_bf16(v[i][0] * r * g[0], v[i][1] * r * g[1]); w.y = cvt_pk_bf16(v[i][2] * r * g[2], v[i][3] * r * g[3]);
                *(u32x2*)(d2 + (size_t)row * D + i * 256 + lane * 4) = w; }
        }
        if (fout) {
#pragma unroll
            for (int i = 0; i < 4; ++i) { const f32x4 g = *(const f32x4*)(g1 + i * 256 + lane * 4); *(f32x4*)(fout + (size_t)row * D + i * 256 + lane * 4) = v[i] * r * g; }
        }
    }
}

template <int HD> DI unsigned k_off(int key, int ch) { const int sw = (HD == 128) ? (key & 15) : ((key >> 1) & 7); return (unsigned)(key * (HD * 2) + ((ch ^ sw) << 4)); }
DI unsigned vt_off(int d, int key) { return (unsigned)(d * 512 + ((((key >> 2) ^ (d & 31))) << 3) + ((key & 3) << 1)); }
DI int crow(int r, int hi) { return (r & 3) + 8 * (r >> 2) + 4 * hi; }
#define MFMA32(a, b, c) __builtin_amdgcn_mfma_f32_32x32x16_bf16((a), (b), (c), 0, 0, 0)

template <int HD, int NKT, class SF>
DI void attn_core(const LAS unsigned char* Kl, const LAS unsigned char* Vl, int kt0, const bf16x8 (&qf)[HD / 16], const SF& sf, float sink, f32x16 (&o)[HD / 32], int lane) {
    const int l31 = lane & 31, half = lane >> 5;
    float m = sink, lsum = 0.f;
#pragma unroll
    for (int dt = 0; dt < HD / 32; ++dt)
#pragma unroll
        for (int r = 0; r < 16; ++r) o[dt][r] = 0.f;
#pragma nounroll
    for (int t = 0; t < NKT; ++t) {
        const int kt = kt0 + t;
        f32x16 st;
#pragma unroll
        for (int r = 0; r < 16; ++r) st[r] = 0.f;
        const int key = 32 * kt + l31;
#pragma unroll
        for (int ks = 0; ks < HD / 16; ++ks) {
            const bf16x8 a = *(const LAS bf16x8*)(Kl + k_off<HD>(key, 2 * ks + half));
            st = MFMA32(a, qf[ks], st);
        }
        float mc = -INFINITY;
#pragma unroll
        for (int r = 0; r < 16; ++r) { const float s = sf(st[r], 32 * kt + crow(r, half)); st[r] = s; mc = fmaxf(mc, s); }
        mc = fmaxf(mc, __shfl_xor(mc, 32));
        const float mn = fmaxf(m, mc);
        const float alpha = __expf(m - mn);
        m = mn;
        lsum *= alpha;
#pragma unroll
        for (int dt = 0; dt < HD / 32; ++dt)
#pragma unroll
            for (int r = 0; r < 16; ++r) o[dt][r] *= alpha;
#pragma unroll
        for (int r = 0; r < 16; ++r) { const float e = __expf(st[r] - mn); st[r] = e; lsum += e; }
#pragma unroll
        for (int k2 = 0; k2 < 2; ++k2) {
            u32x4 pw;
            pw.x = cvt_pk_bf16(st[8 * k2 + 0], st[8 * k2 + 1]); pw.y = cvt_pk_bf16(st[8 * k2 + 2], st[8 * k2 + 3]);
            pw.z = cvt_pk_bf16(st[8 * k2 + 4], st[8 * k2 + 5]); pw.w = cvt_pk_bf16(st[8 * k2 + 6], st[8 * k2 + 7]);
            const bf16x8 pb = __builtin_bit_cast(bf16x8, pw);
            const int kc = 2 * kt + k2;
#pragma unroll
            for (int dt = 0; dt < HD / 32; ++dt) {
                const int d = 32 * dt + l31;
                const s16x4 v0 = *(const LAS s16x4*)(Vl + d * 512 + (((4 * kc + half) ^ l31) << 3));
                const s16x4 v1 = *(const LAS s16x4*)(Vl + d * 512 + (((4 * kc + 2 + half) ^ l31) << 3));
                const bf16x8 a = __builtin_shufflevector(v0, v1, 0, 1, 2, 3, 4, 5, 6, 7);
                o[dt] = MFMA32(a, pb, o[dt]);
            }
        }
    }
    lsum += __shfl_xor(lsum, 32);
    const float inv = 1.0f / (lsum + __expf(sink - m));
#pragma unroll
    for (int dt = 0; dt < HD / 32; ++dt)
#pragma unroll
        for (int r = 0; r < 16; ++r) o[dt][r] *= inv;
}

template <int HD>
DI void attn_store(const f32x16 (&o)[HD / 32], u16* dstrow, int lane) {
    const int half = lane >> 5;
#pragma unroll
    for (int dt = 0; dt < HD / 32; ++dt)
#pragma unroll
        for (int rq = 0; rq < 4; ++rq) {
            u32x2 w; w.x = cvt_pk_bf16(o[dt][4 * rq + 0], o[dt][4 * rq + 1]); w.y = cvt_pk_bf16(o[dt][4 * rq + 2], o[dt][4 * rq + 3]);
            *(u32x2*)(dstrow + 32 * dt + 8 * rq + 4 * half) = w;
        }
}

DI void vt_scatter(LAS unsigned char* Vl, int key, int ch, u32x4 vv) {
#pragma unroll
    for (int j = 0; j < 8; ++j) {
        const unsigned w = (j >> 1) == 0 ? vv.x : ((j >> 1) == 1 ? vv.y : ((j >> 1) == 2 ? vv.z : vv.w));
        const u16 val = (u16)((j & 1) ? (w >> 16) : (w & 0xffffu));
        *(LAS u16*)(Vl + vt_off(ch * 8 + j, key)) = val;
    }
}

DI void memattn_item(int item, LAS unsigned char* lds, const u16* Z, int ldz, int qcol, const u16* memkv_l, const float* ck_l, const float* cv_l, u16* Y) {
    const int tid = opaque_tid(), wid = tid >> 6, lane = tid & 63, l31 = lane & 31, half = lane >> 5;
    LAS unsigned char* Kl = lds; LAS unsigned char* Vl = lds + 65536;
    const bool prompt = item < 256;
    int b, h, qt = 0;
    if (prompt) { b = item >> 7; h = (item >> 5) & 3; qt = item & 31; } else { const int it = item - 256; b = it >> 2; h = it & 3; }
    if (prompt) {
#pragma unroll 2
        for (int i = 0; i < 8; ++i) {
            const int idx = tid + 512 * i, key = idx >> 4, ch = idx & 15;
            const u16* src = memkv_l + (size_t)(b * 256 + key) * 1024 + h * 128 + ch * 8;
            const u32x4 kv = *(const u32x4*)src; const u32x4 vv = *(const u32x4*)(src + 512);
            *(LAS u32x4*)(Kl + k_off<128>(key, ch)) = kv;
            vt_scatter(Vl, key, ch, vv);
        }
    } else {
#pragma unroll 4
        for (int i = 0; i < 8; ++i) {
            const int idx = tid + 512 * i, key = idx >> 4, ch = idx & 15;
            const size_t so = ((size_t)(b * 256 + key) * 4 + h) * 128 + ch * 8;
            const f32x4 k0 = *(const f32x4*)(ck_l + so), k1 = *(const f32x4*)(ck_l + so + 4), v0 = *(const f32x4*)(cv_l + so), v1 = *(const f32x4*)(cv_l + so + 4);
            *(LAS u32x4*)(Kl + k_off<128>(key, ch)) = pack8(k0, k1);
            vt_scatter(Vl, key, ch, pack8(v0, v1));
        }
    }
    __syncthreads();
    if (prompt || wid == 0) {
        const int row = prompt ? (b * SEQ + qt * 256 + wid * 32 + l31) : (MP + b * 8 + (l31 & 7));
        bf16x8 qf[8];
        const u16* qp = Z + (size_t)row * ldz + qcol + h * 128 + 8 * half;
#pragma unroll
        for (int ks = 0; ks < 8; ++ks) qf[ks] = *(const bf16x8*)(qp + 16 * ks);
        f32x16 o[4];
        attn_core<128, 8>(Kl, Vl, 0, qf, [](float s, int) { return s * 0.08838834764831845f; }, -INFINITY, o, lane);
        if (prompt || l31 < 8) attn_store<128>(o, Y + (size_t)row * 1536 + 1024 + h * 128, lane);
    }
    __syncthreads();
}

DI int t5_bucket(int n) {
    if (n < 16) return n;
    int large = 16 + (int)(logf((float)n / 16.0f) / 2.0794415416798357f * 16.0f);
    return large < 31 ? large : 31;
}
DI void swa_item(int item, LAS unsigned char* lds, const u16* Z  , const u16* KVB, const float* cache_k, const float* cache_v, const float* rel_bias, const float* sinks_j, u16* Y) {
    const int tid = opaque_tid(), wid = tid >> 6, lane = tid & 63, l31 = lane & 31;
    LAS unsigned char* Kl = lds; LAS unsigned char* Vl = lds + 32768; LAS float* biasT = (LAS float*)(lds + 65536);
    const bool prompt = item < 512;
    int b, nb = 1, hkv;
    if (prompt) { b = item >> 8; nb = (item >> 2) & 63; hkv = item & 3; } else { const int it = item - 512; b = it >> 2; hkv = it & 3; }
    { const int g = tid >> 7, dist = tid & 127; biasT[tid] = rel_bias[t5_bucket(dist) * 16 + hkv * 4 + g]; }
    if (prompt) {
#pragma unroll 2
        for (int i = 0; i < 4; ++i) {
            const int idx = tid + 512 * i, key = idx >> 3, ch = idx & 7;
            u32x4 kv = (u32x4){0u, 0u, 0u, 0u}, vv = (u32x4){0u, 0u, 0u, 0u};
            if (nb > 0 || key >= 128) { const u16* src = KVB + (size_t)(b * SEQ + (nb - 1) * 128 + key) * 512 + hkv * 64 + ch * 8; kv = *(const u32x4*)src; vv = *(const u32x4*)(src + 256); }
            *(LAS u32x4*)(Kl + k_off<64>(key, ch)) = kv;
            vt_scatter(Vl, key, ch, vv);
        }
    } else {
#pragma nounroll
        for (int i = 0; i < 3; ++i) {
            const int idx = tid + 512 * i, key = idx >> 3, ch = idx & 7;
            if (key < 160) {
                u32x4 kv = (u32x4){0u, 0u, 0u, 0u}, vv = (u32x4){0u, 0u, 0u, 0u};
                if (key < 128) {
                    const size_t so = ((size_t)(b * 128 + key) * 4 + hkv) * 64 + ch * 8;
                    kv = pack8(*(const f32x4*)(cache_k + so), *(const f32x4*)(cache_k + so + 4));
                    vv = pack8(*(const f32x4*)(cache_v + so), *(const f32x4*)(cache_v + so + 4));
                } else if (key < 136) { const u16* src = KVB + (size_t)(MP + b * 8 + (key - 128)) * 512 + hkv * 64 + ch * 8; kv = *(const u32x4*)src; vv = *(const u32x4*)(src + 256); }
                *(LAS u32x4*)(Kl + k_off<64>(key, ch)) = kv;
                vt_scatter(Vl, key, ch, vv);
            }
        }
    }
    __syncthreads();
    const int ntask = prompt ? 2 : (wid == 0 ? 1 : 0);
    for (int task = 0; task < ntask; ++task) {
        int g, qi, row, kt0, jmin;
        if (prompt) { g = wid >> 1; qi = (wid & 1) * 64 + task * 32 + l31; row = b * SEQ + nb * 128 + qi; kt0 = (wid & 1) * 2 + task; jmin = nb > 0 ? 0 : 128; }
        else { g = l31 >> 3; qi = l31 & 7; row = MP + b * 8 + qi; kt0 = 0; jmin = 0; }
        const int head = hkv * 4 + g;
        bf16x8 qf[4];
        const u16* qp = Z + (size_t)row * 1536 + head * 64 + 8 * (lane >> 5);
#pragma unroll
        for (int ks = 0; ks < 4; ++ks) qf[ks] = *(const bf16x8*)(qp + 16 * ks);
        const float sink = sinks_j[head];
        f32x16 o[2];
        const LAS float* bt = biasT + g * 128;
        attn_core<64, 5>(Kl, Vl, kt0, qf, [=](float s, int j) { const int dist = 128 + qi - j; const bool ok = ((unsigned)dist < 128u) && (j >= jmin); return ok ? s * 0.125f + bt[dist & 127] : -INFINITY; }, sink, o, lane);
        attn_store<64>(o, Y + (size_t)row * 1536 + head * 64, lane);
    }
    __syncthreads();
}

DI void conv_item(int item, const u16* Z  , u16* Y, const float* convw, const float* state_l, float* csp_l, float* css_l) {
    const int tid = opaque_tid(), chunk = tid >> 7, c0 = (tid & 127) * 8;
    const int r0 = item * 32 + chunk * 8;
    const bool sample = r0 >= MP;
    float u1[8], u2[8], w0[8], w1[8], w2[8];
    {
        const f32x4 a0 = *(const f32x4*)(convw + c0), a1 = *(const f32x4*)(convw + c0 + 4), b0 = *(const f32x4*)(convw + D + c0), b1 = *(const f32x4*)(convw + D + c0 + 4),
                    d0 = *(const f32x4*)(convw + 2 * D + c0), d1 = *(const f32x4*)(convw + 2 * D + c0 + 4);
#pragma unroll
        for (int j = 0; j < 4; ++j) { w0[j] = a0[j]; w0[j + 4] = a1[j]; w1[j] = b0[j]; w1[j + 4] = b1[j]; w2[j] = d0[j]; w2[j + 4] = d1[j]; }
    }
    int bs = 0;
    if (!sample) {
        if ((r0 & (SEQ - 1)) == 0) {
#pragma unroll
            for (int j = 0; j < 8; ++j) { u1[j] = 0.f; u2[j] = 0.f; }
        } else {
            const u16* z2 = Z + (size_t)(r0 - 2) * 3584 + c0; const u16* z1 = Z + (size_t)(r0 - 1) * 3584 + c0;
            const u32x4 c2 = *(const u32x4*)(z2 + 1024), x2 = *(const u32x4*)(z2 + 2048), c1 = *(const u32x4*)(z1 + 1024), x1 = *(const u32x4*)(z1 + 2048);
            u2[0] = bf_lo(c2.x) * bf_lo(x2.x); u2[1] = bf_hi(c2.x) * bf_hi(x2.x); u2[2] = bf_lo(c2.y) * bf_lo(x2.y); u2[3] = bf_hi(c2.y) * bf_hi(x2.y);
            u2[4] = bf_lo(c2.z) * bf_lo(x2.z); u2[5] = bf_hi(c2.z) * bf_hi(x2.z); u2[6] = bf_lo(c2.w) * bf_lo(x2.w); u2[7] = bf_hi(c2.w) * bf_hi(x2.w);
            u1[0] = bf_lo(c1.x) * bf_lo(x1.x); u1[1] = bf_hi(c1.x) * bf_hi(x1.x); u1[2] = bf_lo(c1.y) * bf_lo(x1.y); u1[3] = bf_hi(c1.y) * bf_hi(x1.y);
            u1[4] = bf_lo(c1.z) * bf_lo(x1.z); u1[5] = bf_hi(c1.z) * bf_hi(x1.z); u1[6] = bf_lo(c1.w) * bf_lo(x1.w); u1[7] = bf_hi(c1.w) * bf_hi(x1.w);
        }
    } else {
        bs = (r0 - MP) >> 3;
        const float* s2 = state_l + (size_t)(bs * 2) * D + c0; const float* s1 = s2 + D;
        const f32x4 p0 = *(const f32x4*)s2, p1 = *(const f32x4*)(s2 + 4), q0 = *(const f32x4*)s1, q1 = *(const f32x4*)(s1 + 4);
#pragma unroll
        for (int j = 0; j < 4; ++j) { u2[j] = p0[j]; u2[j + 4] = p1[j]; u1[j] = q0[j]; u1[j + 4] = q1[j]; }
    }
#pragma unroll
    for (int i = 0; i < 8; ++i) {
        const u16* z = Z + (size_t)(r0 + i) * 3584 + c0;
        const u32x4 bg = *(const u32x4*)z, cg = *(const u32x4*)(z + 1024), xi = *(const u32x4*)(z + 2048);
        float u0[8], bb[8];
        u0[0] = bf_lo(cg.x) * bf_lo(xi.x); u0[1] = bf_hi(cg.x) * bf_hi(xi.x); u0[2] = bf_lo(cg.y) * bf_lo(xi.y); u0[3] = bf_hi(cg.y) * bf_hi(xi.y);
        u0[4] = bf_lo(cg.z) * bf_lo(xi.z); u0[5] = bf_hi(cg.z) * bf_hi(xi.z); u0[6] = bf_lo(cg.w) * bf_lo(xi.w); u0[7] = bf_hi(cg.w) * bf_hi(xi.w);
        bb[0] = bf_lo(bg.x); bb[1] = bf_hi(bg.x); bb[2] = bf_lo(bg.y); bb[3] = bf_hi(bg.y); bb[4] = bf_lo(bg.z); bb[5] = bf_hi(bg.z); bb[6] = bf_lo(bg.w); bb[7] = bf_hi(bg.w);
        float y[8];
#pragma unroll
        for (int j = 0; j < 8; ++j) { y[j] = bb[j] * (w0[j] * u2[j] + w1[j] * u1[j] + w2[j] * u0[j]); u2[j] = u1[j]; u1[j] = u0[j]; }
        u32x4 w; w.x = cvt_pk_bf16(y[0], y[1]); w.y = cvt_pk_bf16(y[2], y[3]); w.z = cvt_pk_bf16(y[4], y[5]); w.w = cvt_pk_bf16(y[6], y[7]);
        *(u32x4*)(Y + (size_t)(r0 + i) * 1536 + c0) = w;
    }
    float* so = nullptr;
    if (!sample) { if ((r0 & (SEQ - 1)) == SEQ - 8) so = csp_l + (size_t)((r0 >> 13) * 2) * D + c0; }
    else so = css_l + (size_t)(bs * 2) * D + c0;
    if (so) {
        *(f32x4*)so = (f32x4){u2[0], u2[1], u2[2], u2[3]}; *(f32x4*)(so + 4) = (f32x4){u2[4], u2[5], u2[6], u2[7]};
        *(f32x4*)(so + D) = (f32x4){u1[0], u1[1], u1[2], u1[3]}; *(f32x4*)(so + D + 4) = (f32x4){u1[4], u1[5], u1[6], u1[7]};
    }
}

DI void resid_finalize(u16* XB, const float* P, float* ssw, const float* ssq) {
    const int tid = opaque_tid(), lane = tid & 63, wid = tid >> 6;
    for (int row = blockIdx.x * NTHR + tid; row < MP; row += gridDim.x * NTHR) {
        const f32x4* q = (const f32x4*)(ssq + (size_t)row * 16); const f32x4 a = q[0], b = q[1], c = q[2], d = q[3];
        ssw[row] = (((a[0] + a[1]) + (a[2] + a[3])) + ((b[0] + b[1]) + (b[2] + b[3]))) + (((c[0] + c[1]) + (c[2] + c[3])) + ((d[0] + d[1]) + (d[2] + d[3])));
    }
    for (int row = blockIdx.x * 8 + wid; row < MT; row += gridDim.x * 8) {
        if (row < MP) continue;
        u16* xr = XB + (size_t)row * D;
        float ss = 0.f;
#pragma unroll
        for (int i = 0; i < 4; ++i) {
            const u32x2 xb = *(const u32x2*)(xr + i * 256 + lane * 4);
            f32x4 v = (f32x4){bf_lo(xb.x), bf_hi(xb.x), bf_lo(xb.y), bf_hi(xb.y)};
#pragma unroll
            for (int sp = 0; sp < NSPLIT; ++sp) v = v + *(const f32x4*)(P + ((size_t)sp * MS + (row - MP)) * D + i * 256 + lane * 4);
            ss += v[0] * v[0] + v[1] * v[1] + v[2] * v[2] + v[3] * v[3];
            u32x2 w; w.x = cvt_pk_bf16(v[0], v[1]); w.y = cvt_pk_bf16(v[2], v[3]);
            *(u32x2*)(xr + i * 256 + lane * 4) = w;
        }
        ss = wave_sum(ss);
        if (lane == 0) ssw[row] = ss;
    }
}

struct GemmDesc { const u16* A; const u16* Bt; int M, N, K, G, c, ns; Epi E; };
DI bool make_gemm(const Params& p, int l, int s, int gi, GemmDesc& d) {
    unsigned char* ws = p.ws;
    const int G = gridDim.x, bid = blockIdx.x;
    u16* XN = (u16*)(ws + WS_XN); u16* H = (u16*)(ws + WS_H);
    d.M = MT; d.K = D; d.G = G; d.c = bid; d.ns = 0; d.E.O = nullptr; d.E.ldc = 0; d.E.F0 = nullptr; d.E.F1 = nullptr; d.E.s = 1.0f;
    d.E.SSP = nullptr;
    float* SSP = (float*)(ws + WS_SSP);
    const float* ssr = (s == 0) ? (l == 0 ? SSP + (size_t)12 * MT : SSP + (size_t)(3 * l - 1) * MT) : SSP + (size_t)(3 * l + 1) * MT;
    if (s == 0 || s == 7) {
        if (gi == 0) { d.A = XN; d.Bt = (const u16*)(ws + (s == 0 ? WS_WGU1 : WS_WGU2) + l * SZ_WGU); d.N = 5632; d.E.mode = EM_SWIGLU; d.E.O = H; d.E.SSP = (float*)ssr; return true; }
        if (gi == 1 && s == 0 && l == 0) {
            const int c = bid - (G - 32); const int ml = c >= 0 ? (c >> 3) : 0;
            d.A = (const u16*)(ws + WS_MEMN) + (size_t)ml * 512 * 1024; d.Bt = (const u16*)(ws + WS_WMEM + ml * SZ_WMEM); d.M = 512; d.N = 1024; d.G = 8; d.c = c >= 0 ? (c & 7) : -1;
            d.E.mode = EM_MEMKV; d.E.O = (u16*)(ws + WS_MEMKV) + (size_t)ml * 512 * 1024; d.E.ldc = 1024; d.E.F0 = p.out + O_MKP + (size_t)ml * 512 * 512; d.E.F1 = p.out + O_MVP + (size_t)ml * 512 * 512; return true; }
        if (gi == 1 && s == 0 && l == 2) {
            d.A = XN; d.Bt = (const u16*)(ws + WS_WKV); d.N = 512; d.E.mode = EM_KV; d.E.O = (u16*)(ws + WS_KVB); d.E.ldc = 512; d.E.F0 = p.out; d.E.SSP = SSP + (size_t)5 * MT; return true; }
        return false;
    }
    if (gi != 0) return false;
    if (s == 1 || s == 8) { d.A = H; d.K = FF; d.Bt = (const u16*)(ws + (s == 1 ? WS_WD1 : WS_WD2) + l * SZ_WD); d.N = D; d.E.mode = EM_RESID; d.E.O = XN; d.E.s = 0.5f; d.E.SSP = (float*)(ws + WS_SSQ); d.ns = NSPLIT; d.E.F1 = (float*)(ws + WS_P); return true; }
    if (s == 5) { d.A = (const u16*)(ws + WS_Y); d.K = 1536; d.Bt = (const u16*)(ws + (l < 2 ? WS_WOUTA + l * SZ_WOUT : WS_WOUTB + (l - 2) * SZ_WOUT)); d.N = D; d.E.mode = EM_RESID; d.E.O = XN; d.E.SSP = (float*)(ws + WS_SSQ); d.ns = NSPLIT; d.E.F1 = (float*)(ws + WS_P); return true; }
    if (s == 3) { const int N = l < 2 ? 3584 : 1536; d.A = XN; d.Bt = (const u16*)(ws + (l < 2 ? WS_WINA + l * SZ_WINA : WS_WINB + (l - 2) * SZ_WINB)); d.N = N; d.E.mode = EM_BF16; d.E.O = (u16*)(ws + WS_Z); d.E.ldc = N; d.E.SSP = SSP + (size_t)(3 * l) * MT; return true; }
    return false;
}

DI void run_phase(const Params& p, int ph, LAS unsigned char* lds, int rep) {
    unsigned char* ws = p.ws;
    u16* XN = (u16*)(ws + WS_XN);
    const int G = gridDim.x, bid = blockIdx.x;
    const int l = ph == 0 ? 0 : (ph - 1) / 10, s = ph == 0 ? -1 : (ph - 1) % 10;
    if (ph == 0) {
        for (int idx = bid; idx < 1056 + 4 * 128; idx += G) wt_dispatch(p, idx < 1056 ? idx : ((idx - 1056) >> 7) * 2240 + 2112 + ((idx - 1056) & 127), (LAS unsigned*)lds);
    }
    if (s == 2 || s == 6 || s == 9) {
        float* SSP = (float*)(ws + WS_SSP);
        resid_finalize(XN, (const float*)(ws + WS_P), SSP + (size_t)(3 * l + (s == 2 ? 0 : (s == 6 ? 1 : 2))) * MT, (const float*)(ws + WS_SSQ));
        if (!(s == 9 && l == 3)) return;
    }
    if (ph == 0 || (s == 9 && l == 3)) {
        for (int pass = 0; pass < (ph == 0 ? 3 : 1); ++pass) {
            const u16* srcH = nullptr; const float* srcA = nullptr; const float* srcB = nullptr; int rowsA = MT, nrows = MT; const float* g1 = nullptr; u16* d1 = XN; const float* g2 = nullptr; u16* d2 = nullptr; float* sso = nullptr; float* fo = nullptr;
            if (ph == 0) {
                if (pass < 2) { srcA = srcB = p.in[7]; rowsA = nrows = 512; g1 = p.in[22] + (2 * pass) * D; g2 = g1 + D; d1 = (u16*)(ws + WS_MEMN) + (size_t)(2 * pass) * 512 * 1024; d2 = d1 + 512 * 1024; }
                else { srcA = p.in[0]; srcB = p.in[1]; rowsA = MP; sso = (float*)(ws + WS_SSP) + (size_t)12 * MT; }
            } else { srcH = XN; g1 = p.in[28]; d1 = nullptr; fo = p.out + O_Y; }
            norm_phase(srcH, srcA, rowsA, srcB, nrows, g1, d1, g2, d2, sso, fo);
        }
        return;
    }
    if (s == 4) {
        u16* Z = (u16*)(ws + WS_Z); u16* Y = (u16*)(ws + WS_Y);
        const int ldz = l < 2 ? 3584 : 1536, qcol = l < 2 ? 3072 : 1024;
        const u16* memkv_l = (const u16*)(ws + WS_MEMKV) + (size_t)l * 512 * 1024;
        const float* ck_l = p.in[5] + (size_t)l * 128 * 256 * 512; const float* cv_l = p.in[6] + (size_t)l * 128 * 256 * 512;
        const int nitems = l < 2 ? 768 + 544 : 768 + 1024;
        const int nround = (nitems + G - 1) / G, shift = (bid % 3 == 0) ? 0 : (bid % 3 == 1 ? 1 : 3);
        for (int k = 0; k < nround; ++k) {
            const int it = bid + ((k + shift) % nround) * G;
            if (it >= nitems) continue;
            if (it < 768) memattn_item(it, lds, Z, ldz, qcol, memkv_l, ck_l, cv_l, Y);
            else if (l < 2) conv_item(it - 768, Z, Y, p.in[14] + (size_t)l * 3 * D, p.in[2] + (size_t)l * 128 * 2 * D, p.out + O_CSP + (size_t)l * 2 * 2 * D, p.out + O_CSS + (size_t)l * 128 * 2 * D);
            else swa_item(it - 768, lds, Z, (const u16*)(ws + WS_KVB), p.in[3], p.in[4], p.in[20], p.in[19] + (l - 2) * 16, Y);
        }
        return;
    }
    for (int gi = 0; gi < 2; ++gi) {
        GemmDesc d;
        if (!make_gemm(p, l, s, gi, d)) break;
        if (rep && d.E.mode == EM_RESID) { d.E.s = 0.f; d.E.SSP = nullptr; }
        pg8::Gemm g{d.A, d.Bt, d.M, d.N, d.K}; pg8::StaticOrder S; S.init(d.M, d.N, d.K, d.G, d.c, d.ns);
        pg8::gemm_phase(lds, g, S, d.E);
    }
    if (s == 1 || s == 5 || s == 8) wt_deferred(p, l, s, (LAS unsigned*)lds);
    if (s == 5 && l == 0 && (int)blockIdx.x >= 64) {
        const size_t n4 = (size_t)128 * 30720 / 4;
        for (size_t e = (size_t)(bid - 64) * NTHR + opaque_tid(); e < n4; e += (size_t)(G - 64) * NTHR) {
            const size_t f = e * 4, b = f / 30720, rem = f % 30720;
            *(f32x4*)(p.out + O_SKS + b * 32768 + rem) = *(const f32x4*)(p.in[3] + b * 32768 + 2048 + rem);
            *(f32x4*)(p.out + O_SVS + b * 32768 + rem) = *(const f32x4*)(p.in[4] + b * 32768 + 2048 + rem);
        }
    }
}

__host__ __device__ inline bool phase_skipped(int ph) { if (ph == 0) return false; const int l = (ph - 1) / 10, s = (ph - 1) % 10; (void)l; (void)s; return false; }
__global__ void __launch_bounds__(NTHR, 2) mega(Params p) {
    extern __shared__ __attribute__((aligned(16))) unsigned char shm[];
    LAS unsigned char* lds = (LAS unsigned char*)shm;
    volatile LAS unsigned* st = (volatile LAS unsigned*)(lds + STAGE_BYTES);
    if (threadIdx.x < 4) st[threadIdx.x] = 0u;
    __syncthreads();
    XcdBarrier bar; bar.bar = (unsigned*)(p.ws + WS_BAR); bar.x = 0; bar.st = st;
    if (p.ph_hi - p.ph_lo > 1) bar = xcd_barrier_post((unsigned*)(p.ws + WS_BAR), st);
    for (int ph = p.ph_lo; ph < p.ph_hi; ++ph) {
        if (phase_skipped(ph)) continue;
        const int reps = (DUP_MASK != 0 && ((DUP_MASK >> (ph == 0 ? 10 : (ph - 1) % 10)) & 1)) ? 2 : 1;
        for (int rep = 0; rep < reps; ++rep) { run_phase(p, ph, lds, rep); if (DUP_BAR && rep + 1 < reps) xcd_barrier(bar); }
        if (ph + 1 < p.ph_hi) {
            if (ph == p.ph_lo) cg::this_grid().sync();
            else xcd_barrier(bar);
        }
    }
}

extern "C" void kernel_launch(void* const* d_in, const int* in_sizes, int n_in, void* d_out, int out_size, void* d_ws, size_t ws_size, hipStream_t stream) {
    static int grid = 0;
    if (grid == 0) {
        int dev = 0, cus = 0, per_cu = 0;
        hipGetDevice(&dev);
        hipDeviceGetAttribute(&cus, hipDeviceAttributeMultiprocessorCount, dev);
        hipFuncSetAttribute((const void*)mega, hipFuncAttributeMaxDynamicSharedMemorySize, LDS_BYTES);
        hipOccupancyMaxActiveBlocksPerMultiprocessor(&per_cu, (const void*)mega, NTHR, LDS_BYTES);
        if (per_cu < 1) per_cu = 1;
        grid = cus * 1;
        if (ws_size < WS_END) { fprintf(stderr, "kernel_launch: workspace too small (%zu < %zu)\n", ws_size, (size_t)WS_END); }
        (void)hipGetLastError();
    }
    Params p{};
    (void)hipMemsetAsync((unsigned char*)d_ws + WS_BAR, 0, 16384, stream);
    for (int i = 0; i < 29; ++i) p.in[i] = (const float*)d_in[i];
    p.out = (float*)d_out; p.ws = (unsigned char*)d_ws;
#if ONE_LAUNCH
    p.ph_lo = 0; p.ph_hi = NPHASE;
    void* args[] = {&p};
    hipError_t e = hipLaunchCooperativeKernel((const void*)mega, dim3(grid), dim3(NTHR), args, LDS_BYTES, stream);
    if (e != hipSuccess) fprintf(stderr, "cooperative launch failed: %s (grid %d)\n", hipGetErrorString(e), grid);
#else
    for (int ph = 0; ph < NPHASE; ++ph) {
        if (phase_skipped(ph)) continue;
        p.ph_lo = ph; p.ph_hi = ph + 1;
        hipLaunchKernelGGL(mega, dim3(grid), dim3(NTHR), LDS_BYTES, stream, p);
    }
#endif
}
```

```cpp
#include <hip/hip_runtime.h>
#include <hip/hip_cooperative_groups.h>
#include <cstdio>
namespace cg = cooperative_groups;

#ifndef ONE_LAUNCH
#define ONE_LAUNCH 1
#endif
#ifndef DUP_BAR
#define DUP_BAR 0
#endif
#ifndef DUP_MASK
#define DUP_MASK 0
#endif

#define LAS __attribute__((address_space(3)))
#define DI __device__ __forceinline__
typedef unsigned short u16;
typedef short bf16x8 __attribute__((ext_vector_type(8)));
typedef short s16x4 __attribute__((ext_vector_type(4)));
typedef float f32x4 __attribute__((ext_vector_type(4)));
typedef float f32x16 __attribute__((ext_vector_type(16)));
typedef unsigned u32x4 __attribute__((ext_vector_type(4)));
typedef unsigned u32x2 __attribute__((ext_vector_type(2)));

constexpr int D = 1024, FF = 2816, MP = 16384, MS = 1024, MT = MP + MS, SEQ = 8192;
constexpr int NTHR = 512, STAGE_BYTES = 131072, LDS_BYTES = STAGE_BYTES + 16;
constexpr int NPHASE = 41;
constexpr int NSPLIT = 4;

constexpr size_t O_Y = 0;
constexpr size_t O_CSP = (size_t)MT * D;
constexpr size_t O_CSS = O_CSP + 8192;
constexpr size_t O_SKP = O_CSS + 524288;
constexpr size_t O_SVP = O_SKP + 65536;
constexpr size_t O_SKS = O_SVP + 65536;
constexpr size_t O_SVS = O_SKS + 4194304;
constexpr size_t O_MKP = O_SVS + 4194304;
constexpr size_t O_MVP = O_MKP + 1048576;

constexpr size_t WS_X = 0;
constexpr size_t WS_XN = WS_X + (size_t)MT * D * 4;
constexpr size_t WS_XN2 = WS_XN + (size_t)MT * D * 2;
constexpr size_t WS_H = WS_XN2 + (size_t)MT * D * 2;
constexpr size_t WS_Z = WS_H + (size_t)MT * FF * 2;
constexpr size_t WS_Y = WS_Z + (size_t)MT * 3584 * 2;
constexpr size_t WS_KVB = WS_Y + (size_t)MT * 1536 * 2;
constexpr size_t WS_MEMN = WS_KVB + (size_t)MT * 512 * 2;
constexpr size_t WS_MEMKV = WS_MEMN + (size_t)4 * 512 * 1024 * 2;
constexpr size_t WS_W = WS_MEMKV + (size_t)4 * 512 * 1024 * 2;
constexpr size_t SZ_WGU = (size_t)5632 * 1024 * 2, SZ_WD = (size_t)1024 * 2816 * 2, SZ_WINA = (size_t)3584 * 1024 * 2, SZ_WINB = (size_t)1536 * 1024 * 2,
                 SZ_WOUT = (size_t)1024 * 1536 * 2, SZ_WKV = (size_t)512 * 1024 * 2, SZ_WMEM = (size_t)1024 * 1024 * 2;
constexpr size_t WS_WGU1 = WS_W, WS_WD1 = WS_WGU1 + 4 * SZ_WGU, WS_WGU2 = WS_WD1 + 4 * SZ_WD, WS_WD2 = WS_WGU2 + 4 * SZ_WGU, WS_WMEM = WS_WD2 + 4 * SZ_WD,
                 WS_WINA = WS_WMEM + 4 * SZ_WMEM, WS_WOUTA = WS_WINA + 2 * SZ_WINA, WS_WINB = WS_WOUTA + 2 * SZ_WOUT, WS_WOUTB = WS_WINB + 2 * SZ_WINB,
                 WS_WKV = WS_WOUTB + 2 * SZ_WOUT, WS_BAR = WS_WKV + SZ_WKV, WS_SSP = WS_BAR + 16384, WS_SSQ = WS_SSP + (size_t)13 * MT * 4, WS_P = WS_SSQ + (size_t)MT * 16 * 4,
                 WS_END = WS_P + (size_t)NSPLIT * MS * D * 4;

struct Params {
    const float* in[29];
    float* out;
    unsigned char* ws;
    int ph_lo, ph_hi;
};

DI unsigned cvt_pk_bf16(float lo, float hi) { unsigned r; asm("v_cvt_pk_bf16_f32 %0, %1, %2" : "=v"(r) : "v"(lo), "v"(hi)); return r; }
DI float bf_lo(unsigned w) { return __uint_as_float(w << 16); }
DI float bf_hi(unsigned w) { return __uint_as_float(w & 0xffff0000u); }
DI float wave_sum(float v) {
#pragma unroll
    for (int o = 32; o >= 1; o >>= 1) v += __shfl_xor(v, o);
    return v;
}
DI int opaque_tid() { int t = threadIdx.x; asm volatile("" : "+v"(t)); return t; }
DI u32x4 pack8(f32x4 a, f32x4 b) { u32x4 w; w.x = cvt_pk_bf16(a[0], a[1]); w.y = cvt_pk_bf16(a[2], a[3]); w.z = cvt_pk_bf16(b[0], b[1]); w.w = cvt_pk_bf16(b[2], b[3]); return w; }
DI float silu_f(float x) { return x * __builtin_amdgcn_rcpf(1.0f + __expf(-x)); }

#define XB_TMO      128
#define XB_XCNT(j)  (256  + 64 * (j))
#define XB_XSUB(j)  (1280 + 64 * (j))
#define XB_XGEN(j)  (2304 + 64 * (j))
#define XB_TOP      3328
#define XB_TOPGEN   3392
#define XCD_BAR_WORDS 3456
#define XB_SPIN_CAP (1u << 22)
DI unsigned xb_ld(unsigned* p)              { return __hip_atomic_load(p, __ATOMIC_RELAXED, __HIP_MEMORY_SCOPE_AGENT); }
DI unsigned xb_add(unsigned* p, unsigned v) { return __hip_atomic_fetch_add(p, v, __ATOMIC_RELAXED, __HIP_MEMORY_SCOPE_AGENT); }
DI unsigned xb_xcc_id() { return (unsigned)__builtin_amdgcn_s_getreg((3 << 11) | 20) & 0xFu; }
#define XB_SPIN(cond, bar) do { unsigned _sp = 0; while (cond) { __builtin_amdgcn_s_sleep(1); \
    if ((++_sp & 255u) == 0u) { if (xb_ld(&(bar)[XB_TMO])) break; if (_sp > XB_SPIN_CAP) { atomicAdd(&(bar)[XB_TMO], 1u); break; } } } } while (0)
struct XcdBarrier { unsigned* bar; unsigned x; volatile LAS unsigned* st; };
DI XcdBarrier xcd_barrier_post(unsigned* bar, volatile LAS unsigned* st) {
    XcdBarrier b; b.bar = bar; b.x = xb_xcc_id(); b.st = st;
    if (threadIdx.x == 0) (void)xb_add(&bar[XB_XCNT(b.x)], 1u);
    return b;
}
DI void xcd_barrier_complete(unsigned* bar, unsigned x, unsigned& nloc, unsigned& nx) {
    const unsigned G = gridDim.x * gridDim.y * gridDim.z;
    unsigned sum, cnt, mine, sp = 0u;
    for (;;) {
        sum = 0u; cnt = 0u; mine = 0u;
#pragma unroll
        for (unsigned j = 0; j < 16; ++j) { const unsigned c = xb_ld(&bar[XB_XCNT(j)]); sum += c; cnt += (c > 0u) ? 1u : 0u; mine = (j == x) ? c : mine; }
        if (sum == G) break;
        __builtin_amdgcn_s_sleep(1);
        if ((++sp & 255u) == 0u) { if (xb_ld(&bar[XB_TMO])) break; if (sp > XB_SPIN_CAP) { atomicAdd(&bar[XB_TMO], 1u); break; } }
    }
    nloc = mine > 0u ? mine : 1u; nx = cnt > 0u ? cnt : 1u;
}
DI void xcd_barrier(const XcdBarrier& b) {
    asm volatile("s_waitcnt vmcnt(0)" ::: "memory");
    __syncthreads();
    if (threadIdx.x == 0) {
        unsigned* bar = b.bar;
        __builtin_amdgcn_s_waitcnt(0);
        unsigned nloc = b.st[0], nx = b.st[1];
        if (nloc == 0u) { xcd_barrier_complete(bar, b.x, nloc, nx); b.st[0] = nloc; b.st[1] = nx; }
        const unsigned old = xb_add(&bar[XB_XSUB(b.x)], 1u);
        const unsigned gen = old / nloc;
        if (old + 1u == (gen + 1u) * nloc) {
            __builtin_amdgcn_fence(__ATOMIC_RELEASE, "agent");
            asm volatile("s_waitcnt vmcnt(0)" ::: "memory");
            const unsigned og = xb_add(&bar[XB_TOP], 1u);
            const unsigned tg = og / nx;
            if (og + 1u == (tg + 1u) * nx) xb_add(&bar[XB_TOPGEN], 1u);
            else XB_SPIN(xb_ld(&bar[XB_TOPGEN]) == tg, bar);
            __builtin_amdgcn_fence(__ATOMIC_ACQUIRE, "agent");
            xb_add(&bar[XB_XGEN(b.x)], 1u);
            asm volatile("s_waitcnt vmcnt(0)" ::: "memory");
        } else {
            XB_SPIN(xb_ld(&bar[XB_XGEN(b.x)]) == gen, bar);
            __builtin_amdgcn_fence(__ATOMIC_ACQUIRE, "agent");
            asm volatile("s_waitcnt vmcnt(0)" ::: "memory");
        }
    }
    __syncthreads();
}

namespace pg8 {
constexpr int BM = 256, BK = 64, HALF = 128, HTB = HALF * BK * 2, NXCD = 8, WGM = 4;
DI int lds_byte(int r, int c) { const int st = (r >> 4) * 2 + (c >> 5), rr = r & 15, cc = c & 31, ob = rr * 64 + cc * 2; return st * 1024 + (ob ^ (((ob >> 9) & 1) << 5)); }
DI void stage_rc(int b, int& R, int& C) { const int st = b / 1024, sb = b % 1024, swz = sb ^ (((sb >> 9) & 1) << 5); R = (st >> 1) * 16 + swz / 64; C = (st & 1) * 32 + (swz % 64) / 2; }
DI int perm32(int rho) { const int n = rho >> 4, i = rho & 15; return 8 * (i >> 2) + 4 * n + (i & 3); }
struct Unit { int pm, pn, k0, nt, part; };
struct Gemm { const u16* A; const u16* Bt; int M, N, K; };
struct StaticOrder {
    int nM, nN, nwg, G, c, ntk, ns, nMall;
    DI void init(int M, int N, int K, int G_, int c_, int ns_) { nMall = M / BM; nM = ns_ ? MP / BM : nMall; nN = N / BM; nwg = nM * nN; G = G_; c = c_; ntk = K / BK; ns = ns_; }
    DI Unit next(int i) const {
        Unit u; u.pm = 0; u.pn = 0; u.k0 = 0; u.nt = 0; u.part = -1;
        const long L = (long)i * G + c; if (c < 0) return u;
        if (L >= nwg) {
            if (ns == 0) return u;
            const int j = (int)(L - nwg); if (j >= (nMall - nM) * nN * ns) return u;
            const int tile = j / ns, sp = j % ns, pairs = ntk >> 1, base = pairs / ns, rem = pairs % ns;
            u.pm = nM + tile / nN; u.pn = tile % nN; u.part = sp;
            u.k0 = 2 * (sp * base + (sp < rem ? sp : rem)); u.nt = 2 * (base + (sp < rem ? 1 : 0));
            return u;
        }
        int wgid = (int)L; { const int q = nwg / NXCD, r = nwg % NXCD, xcd = wgid % NXCD, off = wgid / NXCD; wgid = (xcd < r ? xcd * (q + 1) : r * (q + 1) + (xcd - r) * q) + off; }
        const int nig = WGM * nN, gid = wgid / nig, fm = gid * WGM, gsz = (nM - fm) < WGM ? (nM - fm) : WGM;
        u.pm = fm + ((wgid % nig) % gsz); u.pn = (wgid % nig) / gsz; u.nt = ntk; return u;
    }
};

template <class Epi>
DI void gemm_phase(LAS unsigned char* lds, const Gemm g, const StaticOrder& S, const Epi& E) {
    const int tid = opaque_tid(), wid = __builtin_amdgcn_readfirstlane(tid >> 6), lane = tid & 63, wr = wid >> 2, wc = wid & 3, fr = lane & 15, fq = lane >> 4;
    const int K = g.K;
    unsigned voffA[2], voffB[2];
#pragma unroll
    for (int i = 0; i < 2; ++i) { int R, C; stage_rc(tid * 16 + i * 8192, R, C); const int Rb = Epi::PERM ? ((R & ~31) + perm32(R & 31)) : R;
        voffA[i] = (unsigned)(R * K + C) * 2u; voffB[i] = (unsigned)(Rb * K + C) * 2u; }
    const size_t kstep = (size_t)(BK * 2);
    const size_t hstep = (size_t)HALF * K * 2;
    const size_t tstep = 2 * hstep;
    const unsigned ldsw = (unsigned)wid * 1024u;
    const int aoff = lds_byte(wr * 64 + fr, fq * 8), boff = lds_byte(wc * 32 + fr, fq * 8);
#define PG8_SA(b, h) (((b) * 2 + (h)) * HTB)
#define PG8_SB(b, h) ((4 + (b) * 2 + (h)) * HTB)
#define PG8_STAGE(bufoff, gbase, voff) do { _Pragma("unroll") for (int _i = 0; _i < 2; ++_i) \
        __builtin_amdgcn_global_load_lds((const unsigned*)((const char*)(gbase) + (voff)[_i]), (LAS unsigned*)(lds + (bufoff) + ldsw + _i * 8192), 16, 0, 0); } while (0)
#define PG8_LDA(dst, b, h) do { _Pragma("unroll") for (int m = 0; m < 4; ++m) _Pragma("unroll") for (int k = 0; k < 2; ++k) dst[m][k] = *(const LAS bf16x8*)(lds + PG8_SA(b, h) + aoff + m * 2048 + k * 1024); } while (0)
#define PG8_LDB(dst, b, h) do { _Pragma("unroll") for (int n = 0; n < 2; ++n) _Pragma("unroll") for (int k = 0; k < 2; ++k) dst[n][k] = *(const LAS bf16x8*)(lds + PG8_SB(b, h) + boff + n * 2048 + k * 1024); } while (0)
#define PG8_MMA(ai, bj, At, Bt) do { __builtin_amdgcn_s_setprio(1); _Pragma("unroll") for (int m = 0; m < 4; ++m) _Pragma("unroll") for (int n = 0; n < 2; ++n) _Pragma("unroll") for (int k = 0; k < 2; ++k) \
        acc[ai][bj][m][n] = __builtin_amdgcn_mfma_f32_16x16x32_bf16(Bt[n][k], At[m][k], acc[ai][bj][m][n], 0, 0, 0); __builtin_amdgcn_s_setprio(0); } while (0)
#define PG8_WAIT_V(n) asm volatile("s_waitcnt vmcnt(" #n ")" ::: "memory")
#define PG8_WAIT_L(n) asm volatile("s_waitcnt lgkmcnt(" #n ")" ::: "memory")
#define PG8_BAR __builtin_amdgcn_s_barrier()
#define PG8_SCHED __builtin_amdgcn_sched_barrier(0)
    Unit cur = S.next(0), nxt; int ui = 0;
    if (cur.nt == 0) return;
    f32x4 acc[2][2][4][2];
#pragma unroll
    for (int a = 0; a < 2; ++a)
#pragma unroll
        for (int b = 0; b < 2; ++b)
#pragma unroll
            for (int m = 0; m < 4; ++m)
#pragma unroll
                for (int n = 0; n < 2; ++n) acc[a][b][m][n] = (f32x4){0.f, 0.f, 0.f, 0.f};
    bf16x8 At[4][2], B0[2][2], B1[2][2];
    const char* cA = (const char*)g.A + (size_t)cur.pm * tstep + (size_t)cur.k0 * kstep; const char* cB = (const char*)g.Bt + (size_t)cur.pn * tstep + (size_t)cur.k0 * kstep;
    float rsum[8];
#pragma unroll
    for (int k = 0; k < 8; ++k) rsum[k] = 0.f;
    E.load_rs(cur, wr, fr, rsum);
    PG8_STAGE(PG8_SB(0, 0), cB, voffB); PG8_STAGE(PG8_SB(0, 1), cB + hstep, voffB); PG8_STAGE(PG8_SA(0, 0), cA, voffA); PG8_STAGE(PG8_SA(0, 1), cA + hstep, voffA);
    if (wr == 1) PG8_BAR;
    PG8_WAIT_V(2); PG8_BAR;
    PG8_STAGE(PG8_SB(1, 0), cB + kstep, voffB); PG8_STAGE(PG8_SA(1, 0), cA + kstep, voffA); PG8_STAGE(PG8_SB(1, 1), cB + hstep + kstep, voffB);
    PG8_WAIT_V(6); PG8_BAR;
    for (;;) {
        nxt = S.next(ui + 1);
        const bool has_next = nxt.nt != 0;
        const char* nA = has_next ? (const char*)g.A + (size_t)nxt.pm * tstep + (size_t)nxt.k0 * kstep : cA; const char* nB = has_next ? (const char*)g.Bt + (size_t)nxt.pn * tstep + (size_t)nxt.k0 * kstep : cB;
        const int nt = cur.nt;
        for (int t = 0; t < nt; t += 2) {
            const bool last = (t == nt - 2);
            const char* a1 = cA + (size_t)(t + 1) * kstep;
            const char* a2 = last ? nA : cA + (size_t)(t + 2) * kstep; const char* b2 = last ? nB : cB + (size_t)(t + 2) * kstep;
            const char* a3 = a2 + kstep; const char* b3 = b2 + kstep;
            PG8_LDB(B0, 0, 0); PG8_LDB(B1, 0, 1); PG8_SCHED; PG8_LDA(At, 0, 0); PG8_STAGE(PG8_SA(1, 1), a1 + hstep, voffA);
            PG8_WAIT_V(8); PG8_WAIT_L(0); PG8_BAR; PG8_MMA(0, 0, At, B0); PG8_MMA(0, 1, At, B1); PG8_BAR; PG8_SCHED;
            PG8_LDA(At, 0, 1); PG8_STAGE(PG8_SB(0, 0), b2, voffB); PG8_STAGE(PG8_SB(0, 1), b2 + hstep, voffB); PG8_STAGE(PG8_SA(0, 0), a2, voffA);
            PG8_WAIT_V(8); PG8_WAIT_L(0); PG8_BAR; PG8_MMA(1, 0, At, B0); PG8_MMA(1, 1, At, B1); PG8_BAR; PG8_SCHED;
            PG8_LDB(B0, 1, 0); PG8_LDB(B1, 1, 1); PG8_SCHED; PG8_LDA(At, 1, 0); PG8_STAGE(PG8_SA(0, 1), a2 + hstep, voffA);
            PG8_WAIT_V(8); PG8_WAIT_L(0); PG8_BAR; PG8_MMA(0, 0, At, B0); PG8_MMA(0, 1, At, B1); PG8_BAR; PG8_SCHED;
            PG8_LDA(At, 1, 1); PG8_STAGE(PG8_SB(1, 0), b3, voffB); PG8_STAGE(PG8_SB(1, 1), b3 + hstep, voffB); PG8_STAGE(PG8_SA(1, 0), a3, voffA);
            PG8_WAIT_V(8); PG8_WAIT_L(0); PG8_BAR; PG8_MMA(1, 0, At, B0); PG8_MMA(1, 1, At, B1); PG8_BAR; PG8_SCHED;
        }
        if (wr == 0) PG8_BAR;
        E(acc, cur, wr, wc, fr, fq, rsum);
        if (!has_next) break;
        E.load_rs(nxt, wr, fr, rsum);
#pragma unroll
        for (int a = 0; a < 2; ++a)
#pragma unroll
            for (int b = 0; b < 2; ++b)
#pragma unroll
                for (int m = 0; m < 4; ++m)
#pragma unroll
                    for (int n = 0; n < 2; ++n) acc[a][b][m][n] = (f32x4){0.f, 0.f, 0.f, 0.f};
        cur = nxt; cA = nA; cB = nB; ++ui;
        if (wr == 1) PG8_BAR;
    }
    PG8_WAIT_V(0);
    PG8_BAR;
#undef PG8_SA
#undef PG8_SB
#undef PG8_STAGE
#undef PG8_LDA
#undef PG8_LDB
#undef PG8_MMA
#undef PG8_WAIT_V
#undef PG8_WAIT_L
#undef PG8_BAR
#undef PG8_SCHED
}
}
using pg8::Unit;

enum { EM_SWIGLU = 0, EM_RESID = 1, EM_BF16 = 2, EM_KV = 3, EM_MEMKV = 4, EM_WINA = 5 };
struct Epi {
    static constexpr bool PERM = true;
    int mode; u16* O; int ldc; float* F0; float* F1; float s;
    float* SSP;
    DI void load_rs(const Unit& u, int wr, int fr, float (&rsum)[8]) const {
        if (SSP && mode != EM_RESID) {
#pragma unroll
            for (int k = 0; k < 8; ++k) rsum[k] = SSP[u.pm * 256 + (k >> 2) * 128 + wr * 64 + (k & 3) * 16 + fr];
        }
    }
    DI float row_rs(float t) const { return SSP ? rsqrtf(t * (1.0f / D) + 1e-5f) : 1.0f; }
    DI void operator()(const f32x4 (&acc)[2][2][4][2], const Unit& u, int wr, int wc, int fr, int fq, const float (&rsum)[8]) const {
        const int row0 = u.pm * 256 + wr * 64 + fr, cin = wc * 32 + 8 * fq;
        if (mode == EM_SWIGLU) {
#pragma unroll
            for (int ai = 0; ai < 2; ++ai)
#pragma unroll
                for (int m = 0; m < 4; ++m) {
                    u16* rowp = O + (size_t)(row0 + ai * 128 + m * 16) * FF + u.pn * 128 + cin;
                    const float rs = row_rs(rsum[ai * 4 + m]);
                    const f32x4 g0 = acc[ai][0][m][0] * rs, g1 = acc[ai][0][m][1] * rs, u0 = acc[ai][1][m][0] * rs, u1 = acc[ai][1][m][1] * rs;
                    u32x4 w;
                    w.x = cvt_pk_bf16(silu_f(g0[0]) * u0[0], silu_f(g0[1]) * u0[1]); w.y = cvt_pk_bf16(silu_f(g0[2]) * u0[2], silu_f(g0[3]) * u0[3]);
                    w.z = cvt_pk_bf16(silu_f(g1[0]) * u1[0], silu_f(g1[1]) * u1[1]); w.w = cvt_pk_bf16(silu_f(g1[2]) * u1[2], silu_f(g1[3]) * u1[3]);
                    *(u32x4*)rowp = w;
                }
        } else if (mode == EM_WINA && u.pn >= 4 && u.pn < 12) {
#pragma unroll
            for (int ai = 0; ai < 2; ++ai)
#pragma unroll
                for (int m = 0; m < 4; ++m) {
                    u16* rowp = O + (size_t)(row0 + ai * 128 + m * 16) * 2560 + 1024 + (u.pn - 4) * 128 + cin;
                    const float rs = row_rs(rsum[ai * 4 + m]), rs2 = rs * rs;
                    const f32x4 u0 = acc[ai][0][m][0] * acc[ai][1][m][0] * rs2, u1 = acc[ai][0][m][1] * acc[ai][1][m][1] * rs2;
                    *(u32x4*)rowp = pack8(u0, u1);
                }
        } else if (mode == EM_RESID && u.part >= 0) {
#pragma unroll
            for (int ai = 0; ai < 2; ++ai)
#pragma unroll
                for (int m = 0; m < 4; ++m) {
                    float* rowp = F1 + ((size_t)u.part * MS + (row0 + ai * 128 + m * 16 - MP)) * D + u.pn * 256 + cin;
#pragma unroll
                    for (int bj = 0; bj < 2; ++bj) { f32x4* p0 = (f32x4*)(rowp + bj * 128); p0[0] = acc[ai][bj][m][0] * s; p0[1] = acc[ai][bj][m][1] * s; }
                }
        } else if (mode == EM_RESID) {
#pragma unroll
            for (int ai = 0; ai < 2; ++ai)
#pragma unroll
                for (int m = 0; m < 4; ++m) {
                    const int row = row0 + ai * 128 + m * 16;
                    u16* rowp = O + (size_t)row * D + u.pn * 256 + cin;
                    float ssq = 0.f;
#pragma unroll
                    for (int bj = 0; bj < 2; ++bj) {
                        const u32x4 xb = *(const u32x4*)(rowp + bj * 128);
                        const f32x4 x0 = (f32x4){bf_lo(xb.x), bf_hi(xb.x), bf_lo(xb.y), bf_hi(xb.y)} + acc[ai][bj][m][0] * s;
                        const f32x4 x1 = (f32x4){bf_lo(xb.z), bf_hi(xb.z), bf_lo(xb.w), bf_hi(xb.w)} + acc[ai][bj][m][1] * s;
                        *(u32x4*)(rowp + bj * 128) = pack8(x0, x1);
                        ssq += (x0[0] * x0[0] + x0[1] * x0[1]) + (x0[2] * x0[2] + x0[3] * x0[3]) + (x1[0] * x1[0] + x1[1] * x1[1]) + (x1[2] * x1[2] + x1[3] * x1[3]);
                    }
                    ssq += __shfl_xor(ssq, 16); ssq += __shfl_xor(ssq, 32);
                    if (fq == 0 && SSP) SSP[(size_t)row * 16 + u.pn * 4 + wc] = ssq;
                }
        } else {
#pragma unroll
            for (int ai = 0; ai < 2; ++ai)
#pragma unroll
                for (int m = 0; m < 4; ++m) {
                    const int r = row0 + ai * 128 + m * 16, col0 = (mode == EM_WINA && u.pn >= 12 ? u.pn - 4 : u.pn) * 256 + cin;
                    u16* rowp = O + (size_t)r * ldc + col0;
                    float* fo = nullptr;
                    if (mode == EM_KV) {
                        if (r < MP) { const int b = r >> 13, t = r & 8191; if (t >= SEQ - 128) fo = F0 + (u.pn ? O_SVP : O_SKP) + (size_t)(b * 128 + (t - (SEQ - 128))) * 256 + cin; }
                        else { const int rs = r - MP, b = rs >> 3, t = rs & 7; fo = F0 + (u.pn ? O_SVS : O_SKS) + (size_t)(b * 128 + 120 + t) * 256 + cin; }
                    } else if (mode == EM_MEMKV) {
                        fo = (col0 < 512 ? F0 + (size_t)r * 512 + col0 : F1 + (size_t)r * 512 + (col0 - 512));
                    }
                    const float rs = row_rs(rsum[ai * 4 + m]);
#pragma unroll
                    for (int bj = 0; bj < 2; ++bj) {
                        const f32x4 v0 = acc[ai][bj][m][0] * rs, v1 = acc[ai][bj][m][1] * rs;
                        u32x4 w; w.x = cvt_pk_bf16(v0[0], v0[1]); w.y = cvt_pk_bf16(v0[2], v0[3]); w.z = cvt_pk_bf16(v1[0], v1[1]); w.w = cvt_pk_bf16(v1[2], v1[3]);
                        *(u32x4*)(rowp + bj * 128) = w;
                        if (fo) { *(f32x4*)(fo + bj * 128) = v0; *(f32x4*)(fo + bj * 128 + 4) = v1; }
                    }
                }
        }
    }
};

DI void wt_tile(const float* __restrict__ src, u16* __restrict__ dst, int K, int N, int mode, int tile, LAS unsigned* T, const float* __restrict__ gain) {
    const int tid = opaque_tid();
    const int nN = N >> 6, nt = tile % nN, kt = tile / nN, k0 = kt * 128, n0 = nt * 64;
    int drow0;
    if (mode == 0) drow0 = n0;
    else if (mode == 3) {
        if (n0 < 1024 || n0 >= 3072) drow0 = n0;
        else if (n0 < 2048) { const int ci = n0 - 1024; drow0 = 1024 + (ci >> 7) * 256 + (ci & 127); }
        else { const int xi = n0 - 2048; drow0 = 1024 + (xi >> 7) * 256 + 128 + (xi & 127); }
    } else drow0 = (n0 >> 7) * 256 + (n0 & 127) + (mode == 2 ? 128 : 0);
#pragma unroll
    for (int pass = 0; pass < 2; ++pass) {
        const int kp = pass * 32 + (tid >> 4), nl = (tid & 15) * 4;
        const float* s = src + (size_t)(k0 + 2 * kp) * N + n0 + nl;
        const float ga = gain ? gain[k0 + 2 * kp] : 1.0f, gb = gain ? gain[k0 + 2 * kp + 1] : 1.0f;
        const f32x4 a = *(const f32x4*)s * ga, b = *(const f32x4*)(s + N) * gb;
        T[(nl + 0) * 65 + kp] = cvt_pk_bf16(a[0], b[0]); T[(nl + 1) * 65 + kp] = cvt_pk_bf16(a[1], b[1]);
        T[(nl + 2) * 65 + kp] = cvt_pk_bf16(a[2], b[2]); T[(nl + 3) * 65 + kp] = cvt_pk_bf16(a[3], b[3]);
    }
    __syncthreads();
    {
        const int n = tid >> 3, c = tid & 7;
        u32x4 w0, w1;
        w0.x = T[n * 65 + c * 8 + 0]; w0.y = T[n * 65 + c * 8 + 1]; w0.z = T[n * 65 + c * 8 + 2]; w0.w = T[n * 65 + c * 8 + 3];
        w1.x = T[n * 65 + c * 8 + 4]; w1.y = T[n * 65 + c * 8 + 5]; w1.z = T[n * 65 + c * 8 + 6]; w1.w = T[n * 65 + c * 8 + 7];
        u16* d = dst + (size_t)(drow0 + n) * K + k0 + c * 16;
        *(u32x4*)d = w0; *(u32x4*)(d + 8) = w1;
    }
    __syncthreads();
}
constexpr int WT_TILES = 11072;
DI void wt_dispatch(const Params& p, int idx, LAS unsigned* T) {
    const float* src; u16* dst; int K, N, mode = 0, tile; const float* gain = nullptr;
    unsigned char* ws = p.ws;
    if (idx < 8960) {
        const int l = idx / 2240, r = idx % 2240; int t = r / 352; if (t > 6) t = 6; tile = r - t * 352;
        if (t == 0) { src = p.in[9] + (size_t)l * D * FF; dst = (u16*)(ws + WS_WGU1 + l * SZ_WGU); K = D; N = FF; mode = 1; gain = p.in[8] + l * D; }
        else if (t == 1) { src = p.in[10] + (size_t)l * D * FF; dst = (u16*)(ws + WS_WGU1 + l * SZ_WGU); K = D; N = FF; mode = 2; gain = p.in[8] + l * D; }
        else if (t == 2) { src = p.in[11] + (size_t)l * D * FF; dst = (u16*)(ws + WS_WD1 + l * SZ_WD); K = FF; N = D; }
        else if (t == 3) { src = p.in[25] + (size_t)l * D * FF; dst = (u16*)(ws + WS_WGU2 + l * SZ_WGU); K = D; N = FF; mode = 1; gain = p.in[24] + l * D; }
        else if (t == 4) { src = p.in[26] + (size_t)l * D * FF; dst = (u16*)(ws + WS_WGU2 + l * SZ_WGU); K = D; N = FF; mode = 2; gain = p.in[24] + l * D; }
        else if (t == 5) { src = p.in[27] + (size_t)l * D * FF; dst = (u16*)(ws + WS_WD2 + l * SZ_WD); K = FF; N = D; }
        else { src = p.in[23] + (size_t)l * D * 1024; dst = (u16*)(ws + WS_WMEM + l * SZ_WMEM); K = D; N = 1024; }
    } else {
        int r = idx - 8960;
        if (r < 896) { const int j = r / 448; tile = r % 448; src = p.in[13] + (size_t)j * D * 3584; dst = (u16*)(ws + WS_WINA + j * SZ_WINA); K = D; N = 3584; mode = 3; gain = p.in[12] + j * D; }
        else if (r < 1280) { r -= 896; const int j = r / 192; tile = r % 192; src = p.in[15] + (size_t)j * 1536 * D; dst = (u16*)(ws + WS_WOUTA + j * SZ_WOUT); K = 1536; N = D; }
        else if (r < 1664) { r -= 1280; const int j = r / 192; tile = r % 192; src = p.in[18] + (size_t)j * D * 1536; dst = (u16*)(ws + WS_WINB + j * SZ_WINB); K = D; N = 1536; gain = p.in[12] + (2 + j) * D; }
        else if (r < 2048) { r -= 1664; const int j = r / 192; tile = r % 192; src = p.in[21] + (size_t)j * 1536 * D; dst = (u16*)(ws + WS_WOUTB + j * SZ_WOUT); K = 1536; N = D; }
        else { tile = r - 2048; src = p.in[17]; dst = (u16*)(ws + WS_WKV); K = D; N = 512; gain = p.in[16]; }
    }
    wt_tile(src, dst, K, N, mode, tile, T, gain);
}

DI void wt_deferred(const Params& p, int l, int s, LAS unsigned* T) {
    const int id = (int)blockIdx.x - 64, n = (int)gridDim.x - 64;
    if (id < 0 || n <= 0) return;
    int lo0 = 0, hi0 = 0, lo1 = 0, hi1 = 0;
    if (s == 1) {
        if (l < 2) { lo0 = 8960 + l * 448; hi0 = lo0 + 448; lo1 = 9856 + l * 192; hi1 = lo1 + 192; }
        else { lo0 = 10240 + (l - 2) * 192; hi0 = lo0 + 192; lo1 = 10624 + (l - 2) * 192; hi1 = lo1 + 192; }
    } else if (s == 5) { lo0 = l * 2240 + 1056; hi0 = lo0 + 1056; }
    else if (l < 3) { lo0 = (l + 1) * 2240; hi0 = lo0 + 1056; if (l == 1) { lo1 = 11008; hi1 = 11072; } }
    for (int idx = lo0 + id; idx < hi0; idx += n) wt_dispatch(p, idx, T);
    for (int idx = lo1 + id; idx < hi1; idx += n) wt_dispatch(p, idx, T);
}

DI void norm_phase(const u16* srcH, const float* srcA, int rowsA, const float* srcB, int nrows, const float* g1, u16* d1, const float* g2, u16* d2, float* ssout, float* fout) {
    const int tid = opaque_tid(), lane = tid & 63, wid = tid >> 6;
    for (int row = blockIdx.x * 8 + wid; row < nrows; row += gridDim.x * 8) {
        f32x4 v[4]; float ss = 0.f;
        if (srcH) {
#pragma unroll
            for (int i = 0; i < 4; ++i) { const u32x2 xb = *(const u32x2*)(srcH + (size_t)row * D + i * 256 + lane * 4); v[i] = (f32x4){bf_lo(xb.x), bf_hi(xb.x), bf_lo(xb.y), bf_hi(xb.y)}; }
        } else {
            const float* s = row < rowsA ? srcA + (size_t)row * D : srcB + (size_t)(row - rowsA) * D;
#pragma unroll
            for (int i = 0; i < 4; ++i) v[i] = *(const f32x4*)(s + i * 256 + lane * 4);
        }
#pragma unroll
        for (int i = 0; i < 4; ++i) ss += v[i][0] * v[i][0] + v[i][1] * v[i][1] + v[i][2] * v[i][2] + v[i][3] * v[i][3];
        ss = wave_sum(ss);
        const float r = rsqrtf(ss * (1.0f / D) + 1e-5f);
        if (ssout) {
            if (lane == 0) ssout[row] = ss;
#pragma unroll
            for (int i = 0; i < 4; ++i) { u32x2 w; w.x = cvt_pk_bf16(v[i][0], v[i][1]); w.y = cvt_pk_bf16(v[i][2], v[i][3]); *(u32x2*)(d1 + (size_t)row * D + i * 256 + lane * 4) = w; }
            continue;
        }
        if (d1) {
#pragma unroll
            for (int i = 0; i < 4; ++i) { const f32x4 g = *(const f32x4*)(g1 + i * 256 + lane * 4); u32x2 w; w.x = cvt_pk_bf16(v[i][0] * r * g[0], v[i][1] * r * g[1]); w.y = cvt_pk_bf16(v[i][2] * r * g[2], v[i][3] * r * g[3]);
                *(u32x2*)(d1 + (size_t)row * D + i * 256 + lane * 4) = w; }
        }
        if (d2) {
#pragma unroll
            for (int i = 0; i < 4; ++i) { const f32x4 g = *(const f32x4*)(g2 + i * 256 + lane * 4); u32x2 w; w.x = cvt_pk_bf16(v[i][0] * r * g[0], v[i][1] * r * g[1]); w.y = cvt_pk_bf16(v[i][2] * r * g[2], v[i][3] * r * g[3]);
                *(u32x2*)(d2 + (size_t)row * D + i * 256 + lane * 4) = w; }
        }
        if (fout) {
#pragma unroll
            for (int i = 0; i < 4; ++i) { const f32x4 g = *(const f32x4*)(g1 + i * 256 + lane * 4); *(f32x4*)(fout + (size_t)row * D + i * 256 + lane * 4) = v[i] * r * g; }
        }
    }
}

template <int HD> DI unsigned k_off(int key, int ch) { const int sw = (HD == 128) ? (key & 15) : ((key >> 1) & 7); return (unsigned)(key * (HD * 2) + ((ch ^ sw) << 4)); }
DI unsigned vt_off(int d, int key) { return (unsigned)(d * 512 + ((((key >> 2) ^ (d & 31))) << 3) + ((key & 3) << 1)); }
DI int crow(int r, int hi) { return (r & 3) + 8 * (r >> 2) + 4 * hi; }
#define MFMA32(a, b, c) __builtin_amdgcn_mfma_f32_32x32x16_bf16((a), (b), (c), 0, 0, 0)

template <int HD, int NKT, class SF>
DI void attn_core(const LAS unsigned char* Kl, const LAS unsigned char* Vl, int kt0, const bf16x8 (&qf)[HD / 16], const SF& sf, float sink, f32x16 (&o)[HD / 32], int lane) {
    const int l31 = lane & 31, half = lane >> 5;
    float m = sink, lsum = 0.f;
#pragma unroll
    for (int dt = 0; dt < HD / 32; ++dt)
#pragma unroll
        for (int r = 0; r < 16; ++r) o[dt][r] = 0.f;
#pragma nounroll
    for (int t = 0; t < NKT; ++t) {
        const int kt = kt0 + t;
        f32x16 st;
#pragma unroll
        for (int r = 0; r < 16; ++r) st[r] = 0.f;
        const int key = 32 * kt + l31;
#pragma unroll
        for (int ks = 0; ks < HD / 16; ++ks) {
            const bf16x8 a = *(const LAS bf16x8*)(Kl + k_off<HD>(key, 2 * ks + half));
            st = MFMA32(a, qf[ks], st);
        }
        float mc = -INFINITY;
#pragma unroll
        for (int r = 0; r < 16; ++r) { const float s = sf(st[r], 32 * kt + crow(r, half)); st[r] = s; mc = fmaxf(mc, s); }
        mc = fmaxf(mc, __shfl_xor(mc, 32));
        const float mn = fmaxf(m, mc);
        const float alpha = __expf(m - mn);
        m = mn;
        lsum *= alpha;
#pragma unroll
        for (int dt = 0; dt < HD / 32; ++dt)
#pragma unroll
            for (int r = 0; r < 16; ++r) o[dt][r] *= alpha;
#pragma unroll
        for (int r = 0; r < 16; ++r) { const float e = __expf(st[r] - mn); st[r] = e; lsum += e; }
#pragma unroll
        for (int k2 = 0; k2 < 2; ++k2) {
            u32x4 pw;
            pw.x = cvt_pk_bf16(st[8 * k2 + 0], st[8 * k2 + 1]); pw.y = cvt_pk_bf16(st[8 * k2 + 2], st[8 * k2 + 3]);
            pw.z = cvt_pk_bf16(st[8 * k2 + 4], st[8 * k2 + 5]); pw.w = cvt_pk_bf16(st[8 * k2 + 6], st[8 * k2 + 7]);
            const bf16x8 pb = __builtin_bit_cast(bf16x8, pw);
            const int kc = 2 * kt + k2;
#pragma unroll
            for (int dt = 0; dt < HD / 32; ++dt) {
                const int d = 32 * dt + l31;
                const s16x4 v0 = *(const LAS s16x4*)(Vl + d * 512 + (((4 * kc + half) ^ l31) << 3));
                const s16x4 v1 = *(const LAS s16x4*)(Vl + d * 512 + (((4 * kc + 2 + half) ^ l31) << 3));
                const bf16x8 a = __builtin_shufflevector(v0, v1, 0, 1, 2, 3, 4, 5, 6, 7);
                o[dt] = MFMA32(a, pb, o[dt]);
            }
        }
    }
    lsum += __shfl_xor(lsum, 32);
    const float inv = 1.0f / (lsum + __expf(sink - m));
#pragma unroll
    for (int dt = 0; dt < HD / 32; ++dt)
#pragma unroll
        for (int r = 0; r < 16; ++r) o[dt][r] *= inv;
}

template <int HD>
DI void attn_store(const f32x16 (&o)[HD / 32], u16* dstrow, int lane) {
    const int half = lane >> 5;
#pragma unroll
    for (int dt = 0; dt < HD / 32; ++dt)
#pragma unroll
        for (int rq = 0; rq < 4; ++rq) {
            u32x2 w; w.x = cvt_pk_bf16(o[dt][4 * rq + 0], o[dt][4 * rq + 1]); w.y = cvt_pk_bf16(o[dt][4 * rq + 2], o[dt][4 * rq + 3]);
            *(u32x2*)(dstrow + 32 * dt + 8 * rq + 4 * half) = w;
        }
}

DI void vt_scatter(LAS unsigned char* Vl, int key, int ch, u32x4 vv) {
#pragma unroll
    for (int j = 0; j < 8; ++j) {
        const unsigned w = (j >> 1) == 0 ? vv.x : ((j >> 1) == 1 ? vv.y : ((j >> 1) == 2 ? vv.z : vv.w));
        const u16 val = (u16)((j & 1) ? (w >> 16) : (w & 0xffffu));
        *(LAS u16*)(Vl + vt_off(ch * 8 + j, key)) = val;
    }
}

DI void memattn_item(int item, LAS unsigned char* lds, const u16* Z, int ldz, int qcol, const u16* memkv_l, const float* ck_l, const float* cv_l, u16* Y) {
    const int tid = opaque_tid(), wid = tid >> 6, lane = tid & 63, l31 = lane & 31, half = lane >> 5;
    LAS unsigned char* Kl = lds; LAS unsigned char* Vl = lds + 65536;
    const bool prompt = item < 256;
    int b, h, qt = 0;
    if (prompt) { b = item >> 7; h = (item >> 5) & 3; qt = item & 31; } else { const int it = item - 256; b = it >> 2; h = it & 3; }
    if (prompt) {
#pragma unroll 2
        for (int i = 0; i < 8; ++i) {
            const int idx = tid + 512 * i, key = idx >> 4, ch = idx & 15;
            const u16* src = memkv_l + (size_t)(b * 256 + key) * 1024 + h * 128 + ch * 8;
            const u32x4 kv = *(const u32x4*)src; const u32x4 vv = *(const u32x4*)(src + 512);
            *(LAS u32x4*)(Kl + k_off<128>(key, ch)) = kv;
            vt_scatter(Vl, key, ch, vv);
        }
    } else {
#pragma unroll 4
        for (int i = 0; i < 8; ++i) {
            const int idx = tid + 512 * i, key = idx >> 4, ch = idx & 15;
            const size_t so = ((size_t)(b * 256 + key) * 4 + h) * 128 + ch * 8;
            const f32x4 k0 = *(const f32x4*)(ck_l + so), k1 = *(const f32x4*)(ck_l + so + 4), v0 = *(const f32x4*)(cv_l + so), v1 = *(const f32x4*)(cv_l + so + 4);
            *(LAS u32x4*)(Kl + k_off<128>(key, ch)) = pack8(k0, k1);
            vt_scatter(Vl, key, ch, pack8(v0, v1));
        }
    }
    __syncthreads();
    if (prompt || wid == 0) {
        const int row = prompt ? (b * SEQ + qt * 256 + wid * 32 + l31) : (MP + b * 8 + (l31 & 7));
        bf16x8 qf[8];
        const u16* qp = Z + (size_t)row * ldz + qcol + h * 128 + 8 * half;
#pragma unroll
        for (int ks = 0; ks < 8; ++ks) qf[ks] = *(const bf16x8*)(qp + 16 * ks);
        f32x16 o[4];
        attn_core<128, 8>(Kl, Vl, 0, qf, [](float s, int) { return s * 0.08838834764831845f; }, -INFINITY, o, lane);
        if (prompt || l31 < 8) attn_store<128>(o, Y + (size_t)row * 1536 + 1024 + h * 128, lane);
    }
    __syncthreads();
}

DI int t5_bucket(int n) {
    if (n < 16) return n;
    int large = 16 + (int)(logf((float)n / 16.0f) / 2.0794415416798357f * 16.0f);
    return large < 31 ? large : 31;
}
DI void swa_item(int item, LAS unsigned char* lds, const u16* Z  , const u16* KVB, const float* cache_k, const float* cache_v, const float* rel_bias, const float* sinks_j, u16* Y) {
    const int tid = opaque_tid(), wid = tid >> 6, lane = tid & 63, l31 = lane & 31;
    LAS unsigned char* Kl = lds; LAS unsigned char* Vl = lds + 32768; LAS float* biasT = (LAS float*)(lds + 65536);
    const bool prompt = item < 512;
    int b, nb = 1, hkv;
    if (prompt) { b = item >> 8; nb = (item >> 2) & 63; hkv = item & 3; } else { const int it = item - 512; b = it >> 2; hkv = it & 3; }
    { const int g = tid >> 7, dist = tid & 127; biasT[tid] = rel_bias[t5_bucket(dist) * 16 + hkv * 4 + g]; }
    if (prompt) {
#pragma unroll 2
        for (int i = 0; i < 4; ++i) {
            const int idx = tid + 512 * i, key = idx >> 3, ch = idx & 7;
            u32x4 kv = (u32x4){0u, 0u, 0u, 0u}, vv = (u32x4){0u, 0u, 0u, 0u};
            if (nb > 0 || key >= 128) { const u16* src = KVB + (size_t)(b * SEQ + (nb - 1) * 128 + key) * 512 + hkv * 64 + ch * 8; kv = *(const u32x4*)src; vv = *(const u32x4*)(src + 256); }
            *(LAS u32x4*)(Kl + k_off<64>(key, ch)) = kv;
            vt_scatter(Vl, key, ch, vv);
        }
    } else {
#pragma nounroll
        for (int i = 0; i < 3; ++i) {
            const int idx = tid + 512 * i, key = idx >> 3, ch = idx & 7;
            if (key < 160) {
                u32x4 kv = (u32x4){0u, 0u, 0u, 0u}, vv = (u32x4){0u, 0u, 0u, 0u};
                if (key < 128) {
                    const size_t so = ((size_t)(b * 128 + key) * 4 + hkv) * 64 + ch * 8;
                    kv = pack8(*(const f32x4*)(cache_k + so), *(const f32x4*)(cache_k + so + 4));
                    vv = pack8(*(const f32x4*)(cache_v + so), *(const f32x4*)(cache_v + so + 4));
                } else if (key < 136) { const u16* src = KVB + (size_t)(MP + b * 8 + (key - 128)) * 512 + hkv * 64 + ch * 8; kv = *(const u32x4*)src; vv = *(const u32x4*)(src + 256); }
                *(LAS u32x4*)(Kl + k_off<64>(key, ch)) = kv;
                vt_scatter(Vl, key, ch, vv);
            }
        }
    }
    __syncthreads();
    const int ntask = prompt ? 2 : (wid == 0 ? 1 : 0);
    for (int task = 0; task < ntask; ++task) {
        int g, qi, row, kt0, jmin;
        if (prompt) { g = wid >> 1; qi = (wid & 1) * 64 + task * 32 + l31; row = b * SEQ + nb * 128 + qi; kt0 = (wid & 1) * 2 + task; jmin = nb > 0 ? 0 : 128; }
        else { g = l31 >> 3; qi = l31 & 7; row = MP + b * 8 + qi; kt0 = 0; jmin = 0; }
        const int head = hkv * 4 + g;
        bf16x8 qf[4];
        const u16* qp = Z + (size_t)row * 1536 + head * 64 + 8 * (lane >> 5);
#pragma unroll
        for (int ks = 0; ks < 4; ++ks) qf[ks] = *(const bf16x8*)(qp + 16 * ks);
        const float sink = sinks_j[head];
        f32x16 o[2];
        const LAS float* bt = biasT + g * 128;
        attn_core<64, 5>(Kl, Vl, kt0, qf, [=](float s, int j) { const int dist = 128 + qi - j; const bool ok = ((unsigned)dist < 128u) && (j >= jmin); return ok ? s * 0.125f + bt[dist & 127] : -INFINITY; }, sink, o, lane);
        attn_store<64>(o, Y + (size_t)row * 1536 + head * 64, lane);
    }
    __syncthreads();
}

DI void conv_item(int item, const u16* Z  , u16* Y, const float* convw, const float* state_l, float* csp_l, float* css_l) {
    const int tid = opaque_tid(), chunk = tid >> 7, c0 = (tid & 127) * 8;
    const int r0 = item * 32 + chunk * 8;
    const bool sample = r0 >= MP;
    float u1[8], u2[8], w0[8], w1[8], w2[8];
    {
        const f32x4 a0 = *(const f32x4*)(convw + c0), a1 = *(const f32x4*)(convw + c0 + 4), b0 = *(const f32x4*)(convw + D + c0), b1 = *(const f32x4*)(convw + D + c0 + 4),
                    d0 = *(const f32x4*)(convw + 2 * D + c0), d1 = *(const f32x4*)(convw + 2 * D + c0 + 4);
#pragma unroll
        for (int j = 0; j < 4; ++j) { w0[j] = a0[j]; w0[j + 4] = a1[j]; w1[j] = b0[j]; w1[j + 4] = b1[j]; w2[j] = d0[j]; w2[j + 4] = d1[j]; }
    }
    int bs = 0;
    if (!sample) {
        if ((r0 & (SEQ - 1)) == 0) {
#pragma unroll
            for (int j = 0; j < 8; ++j) { u1[j] = 0.f; u2[j] = 0.f; }
        } else {
            const u32x4 q2 = *(const u32x4*)(Z + (size_t)(r0 - 2) * 2560 + 1024 + c0), q1 = *(const u32x4*)(Z + (size_t)(r0 - 1) * 2560 + 1024 + c0);
            u2[0] = bf_lo(q2.x); u2[1] = bf_hi(q2.x); u2[2] = bf_lo(q2.y); u2[3] = bf_hi(q2.y); u2[4] = bf_lo(q2.z); u2[5] = bf_hi(q2.z); u2[6] = bf_lo(q2.w); u2[7] = bf_hi(q2.w);
            u1[0] = bf_lo(q1.x); u1[1] = bf_hi(q1.x); u1[2] = bf_lo(q1.y); u1[3] = bf_hi(q1.y); u1[4] = bf_lo(q1.z); u1[5] = bf_hi(q1.z); u1[6] = bf_lo(q1.w); u1[7] = bf_hi(q1.w);
        }
    } else {
        bs = (r0 - MP) >> 3;
        const float* s2 = state_l + (size_t)(bs * 2) * D + c0; const float* s1 = s2 + D;
        const f32x4 p0 = *(const f32x4*)s2, p1 = *(const f32x4*)(s2 + 4), q0 = *(const f32x4*)s1, q1 = *(const f32x4*)(s1 + 4);
#pragma unroll
        for (int j = 0; j < 4; ++j) { u2[j] = p0[j]; u2[j + 4] = p1[j]; u1[j] = q0[j]; u1[j + 4] = q1[j]; }
    }
#pragma unroll
    for (int i = 0; i < 8; ++i) {
        const u16* z = Z + (size_t)(r0 + i) * 2560 + c0;
        const u32x4 bg = *(const u32x4*)z, ug = *(const u32x4*)(z + 1024);
        float u0[8], bb[8];
        u0[0] = bf_lo(ug.x); u0[1] = bf_hi(ug.x); u0[2] = bf_lo(ug.y); u0[3] = bf_hi(ug.y); u0[4] = bf_lo(ug.z); u0[5] = bf_hi(ug.z); u0[6] = bf_lo(ug.w); u0[7] = bf_hi(ug.w);
        bb[0] = bf_lo(bg.x); bb[1] = bf_hi(bg.x); bb[2] = bf_lo(bg.y); bb[3] = bf_hi(bg.y); bb[4] = bf_lo(bg.z); bb[5] = bf_hi(bg.z); bb[6] = bf_lo(bg.w); bb[7] = bf_hi(bg.w);
        float y[8];
#pragma unroll
        for (int j = 0; j < 8; ++j) { y[j] = bb[j] * (w0[j] * u2[j] + w1[j] * u1[j] + w2[j] * u0[j]); u2[j] = u1[j]; u1[j] = u0[j]; }
        u32x4 w; w.x = cvt_pk_bf16(y[0], y[1]); w.y = cvt_pk_bf16(y[2], y[3]); w.z = cvt_pk_bf16(y[4], y[5]); w.w = cvt_pk_bf16(y[6], y[7]);
        *(u32x4*)(Y + (size_t)(r0 + i) * 1536 + c0) = w;
    }
    float* so = nullptr;
    if (!sample) { if ((r0 & (SEQ - 1)) == SEQ - 8) so = csp_l + (size_t)((r0 >> 13) * 2) * D + c0; }
    else so = css_l + (size_t)(bs * 2) * D + c0;
    if (so) {
        *(f32x4*)so = (f32x4){u2[0], u2[1], u2[2], u2[3]}; *(f32x4*)(so + 4) = (f32x4){u2[4], u2[5], u2[6], u2[7]};
        *(f32x4*)(so + D) = (f32x4){u1[0], u1[1], u1[2], u1[3]}; *(f32x4*)(so + D + 4) = (f32x4){u1[4], u1[5], u1[6], u1[7]};
    }
}

DI void resid_finalize(u16* XB, const float* P, float* ssw, const float* ssq) {
    const int tid = opaque_tid(), lane = tid & 63, wid = tid >> 6;
    for (int row = blockIdx.x * NTHR + tid; row < MP; row += gridDim.x * NTHR) {
        const f32x4* q = (const f32x4*)(ssq + (size_t)row * 16); const f32x4 a = q[0], b = q[1], c = q[2], d = q[3];
        ssw[row] = (((a[0] + a[1]) + (a[2] + a[3])) + ((b[0] + b[1]) + (b[2] + b[3]))) + (((c[0] + c[1]) + (c[2] + c[3])) + ((d[0] + d[1]) + (d[2] + d[3])));
    }
    for (int row = blockIdx.x * 8 + wid; row < MT; row += gridDim.x * 8) {
        if (row < MP) continue;
        u16* xr = XB + (size_t)row * D;
        float ss = 0.f;
#pragma unroll
        for (int i = 0; i < 4; ++i) {
            const u32x2 xb = *(const u32x2*)(xr + i * 256 + lane * 4);
            f32x4 v = (f32x4){bf_lo(xb.x), bf_hi(xb.x), bf_lo(xb.y), bf_hi(xb.y)};
#pragma unroll
            for (int sp = 0; sp < NSPLIT; ++sp) v = v + *(const f32x4*)(P + ((size_t)sp * MS + (row - MP)) * D + i * 256 + lane * 4);
            ss += v[0] * v[0] + v[1] * v[1] + v[2] * v[2] + v[3] * v[3];
            u32x2 w; w.x = cvt_pk_bf16(v[0], v[1]); w.y = cvt_pk_bf16(v[2], v[3]);
            *(u32x2*)(xr + i * 256 + lane * 4) = w;
        }
        ss = wave_sum(ss);
        if (lane == 0) ssw[row] = ss;
    }
}

struct GemmDesc { const u16* A; const u16* Bt; int M, N, K, G, c, ns; Epi E; };
DI bool make_gemm(const Params& p, int l, int s, int gi, GemmDesc& d) {
    unsigned char* ws = p.ws;
    const int G = gridDim.x, bid = blockIdx.x;
    u16* XN = (u16*)(ws + WS_XN); u16* H = (u16*)(ws + WS_H);
    d.M = MT; d.K = D; d.G = G; d.c = bid; d.ns = 0; d.E.O = nullptr; d.E.ldc = 0; d.E.F0 = nullptr; d.E.F1 = nullptr; d.E.s = 1.0f;
    d.E.SSP = nullptr;
    float* SSP = (float*)(ws + WS_SSP);
    const float* ssr = (s == 0) ? (l == 0 ? SSP + (size_t)12 * MT : SSP + (size_t)(3 * l - 1) * MT) : SSP + (size_t)(3 * l + 1) * MT;
    if (s == 0 || s == 7) {
        if (gi == 0) { d.A = XN; d.Bt = (const u16*)(ws + (s == 0 ? WS_WGU1 : WS_WGU2) + l * SZ_WGU); d.N = 5632; d.E.mode = EM_SWIGLU; d.E.O = H; d.E.SSP = (float*)ssr; return true; }
        if (gi == 1 && s == 0 && l == 0) {
            const int c = bid - (G - 32); const int ml = c >= 0 ? (c >> 3) : 0;
            d.A = (const u16*)(ws + WS_MEMN) + (size_t)ml * 512 * 1024; d.Bt = (const u16*)(ws + WS_WMEM + ml * SZ_WMEM); d.M = 512; d.N = 1024; d.G = 8; d.c = c >= 0 ? (c & 7) : -1;
            d.E.mode = EM_MEMKV; d.E.O = (u16*)(ws + WS_MEMKV) + (size_t)ml * 512 * 1024; d.E.ldc = 1024; d.E.F0 = p.out + O_MKP + (size_t)ml * 512 * 512; d.E.F1 = p.out + O_MVP + (size_t)ml * 512 * 512; return true; }
        if (gi == 1 && s == 0 && l == 2) {
            d.A = XN; d.Bt = (const u16*)(ws + WS_WKV); d.N = 512; d.E.mode = EM_KV; d.E.O = (u16*)(ws + WS_KVB); d.E.ldc = 512; d.E.F0 = p.out; d.E.SSP = SSP + (size_t)5 * MT; return true; }
        return false;
    }
    if (gi != 0) return false;
    if (s == 1 || s == 8) { d.A = H; d.K = FF; d.Bt = (const u16*)(ws + (s == 1 ? WS_WD1 : WS_WD2) + l * SZ_WD); d.N = D; d.E.mode = EM_RESID; d.E.O = XN; d.E.s = 0.5f; d.E.SSP = (float*)(ws + WS_SSQ); d.ns = NSPLIT; d.E.F1 = (float*)(ws + WS_P); return true; }
    if (s == 5) { d.A = (const u16*)(ws + WS_Y); d.K = 1536; d.Bt = (const u16*)(ws + (l < 2 ? WS_WOUTA + l * SZ_WOUT : WS_WOUTB + (l - 2) * SZ_WOUT)); d.N = D; d.E.mode = EM_RESID; d.E.O = XN; d.E.SSP = (float*)(ws + WS_SSQ); d.ns = NSPLIT; d.E.F1 = (float*)(ws + WS_P); return true; }
    if (s == 3) { const int N = l < 2 ? 3584 : 1536; d.A = XN; d.Bt = (const u16*)(ws + (l < 2 ? WS_WINA + l * SZ_WINA : WS_WINB + (l - 2) * SZ_WINB)); d.N = N; d.E.mode = l < 2 ? EM_WINA : EM_BF16; d.E.O = (u16*)(ws + WS_Z); d.E.ldc = l < 2 ? 2560 : N; d.E.SSP = SSP + (size_t)(3 * l) * MT; return true; }
    return false;
}

DI void run_phase(const Params& p, int ph, LAS unsigned char* lds, int rep) {
    unsigned char* ws = p.ws;
    u16* XN = (u16*)(ws + WS_XN);
    const int G = gridDim.x, bid = blockIdx.x;
    const int l = ph == 0 ? 0 : (ph - 1) / 10, s = ph == 0 ? -1 : (ph - 1) % 10;
    if (ph == 0) {
        for (int idx = bid; idx < 1056 + 4 * 128; idx += G) wt_dispatch(p, idx < 1056 ? idx : ((idx - 1056) >> 7) * 2240 + 2112 + ((idx - 1056) & 127), (LAS unsigned*)lds);
    }
    if (s == 2 || s == 6 || s == 9) {
        float* SSP = (float*)(ws + WS_SSP);
        resid_finalize(XN, (const float*)(ws + WS_P), SSP + (size_t)(3 * l + (s == 2 ? 0 : (s == 6 ? 1 : 2))) * MT, (const float*)(ws + WS_SSQ));
        if (!(s == 9 && l == 3)) return;
    }
    if (ph == 0 || (s == 9 && l == 3)) {
        for (int pass = 0; pass < (ph == 0 ? 3 : 1); ++pass) {
            const u16* srcH = nullptr; const float* srcA = nullptr; const float* srcB = nullptr; int rowsA = MT, nrows = MT; const float* g1 = nullptr; u16* d1 = XN; const float* g2 = nullptr; u16* d2 = nullptr; float* sso = nullptr; float* fo = nullptr;
            if (ph == 0) {
                if (pass < 2) { srcA = srcB = p.in[7]; rowsA = nrows = 512; g1 = p.in[22] + (2 * pass) * D; g2 = g1 + D; d1 = (u16*)(ws + WS_MEMN) + (size_t)(2 * pass) * 512 * 1024; d2 = d1 + 512 * 1024; }
                else { srcA = p.in[0]; srcB = p.in[1]; rowsA = MP; sso = (float*)(ws + WS_SSP) + (size_t)12 * MT; }
            } else { srcH = XN; g1 = p.in[28]; d1 = nullptr; fo = p.out + O_Y; }
            norm_phase(srcH, srcA, rowsA, srcB, nrows, g1, d1, g2, d2, sso, fo);
        }
        return;
    }
    if (s == 4) {
        u16* Z = (u16*)(ws + WS_Z); u16* Y = (u16*)(ws + WS_Y);
        const int ldz = l < 2 ? 2560 : 1536, qcol = l < 2 ? 2048 : 1024;
        const u16* memkv_l = (const u16*)(ws + WS_MEMKV) + (size_t)l * 512 * 1024;
        const float* ck_l = p.in[5] + (size_t)l * 128 * 256 * 512; const float* cv_l = p.in[6] + (size_t)l * 128 * 256 * 512;
        const int nitems = l < 2 ? 768 + 544 : 768 + 1024;
        const int nround = (nitems + G - 1) / G, shift = (bid % 3 == 0) ? 0 : (bid % 3 == 1 ? 1 : 3);
        for (int k = 0; k < nround; ++k) {
            const int it = bid + ((k + shift) % nround) * G;
            if (it >= nitems) continue;
            if (it < 768) memattn_item(it, lds, Z, ldz, qcol, memkv_l, ck_l, cv_l, Y);
            else if (l < 2) conv_item(it - 768, Z, Y, p.in[14] + (size_t)l * 3 * D, p.in[2] + (size_t)l * 128 * 2 * D, p.out + O_CSP + (size_t)l * 2 * 2 * D, p.out + O_CSS + (size_t)l * 128 * 2 * D);
            else swa_item(it - 768, lds, Z, (const u16*)(ws + WS_KVB), p.in[3], p.in[4], p.in[20], p.in[19] + (l - 2) * 16, Y);
        }
        return;
    }
    for (int gi = 0; gi < 2; ++gi) {
        GemmDesc d;
        if (!make_gemm(p, l, s, gi, d)) break;
        if (rep && d.E.mode == EM_RESID) { d.E.s = 0.f; d.E.SSP = nullptr; }
        pg8::Gemm g{d.A, d.Bt, d.M, d.N, d.K}; pg8::StaticOrder S; S.init(d.M, d.N, d.K, d.G, d.c, d.ns);
        pg8::gemm_phase(lds, g, S, d.E);
    }
    if (s == 1 || s == 5 || s == 8) wt_deferred(p, l, s, (LAS unsigned*)lds);
    if (s == 5 && l == 0 && (int)blockIdx.x >= 64) {
        const size_t n4 = (size_t)128 * 30720 / 4;
        for (size_t e = (size_t)(bid - 64) * NTHR + opaque_tid(); e < n4; e += (size_t)(G - 64) * NTHR) {
            const size_t f = e * 4, b = f / 30720, rem = f % 30720;
            *(f32x4*)(p.out + O_SKS + b * 32768 + rem) = *(const f32x4*)(p.in[3] + b * 32768 + 2048 + rem);
            *(f32x4*)(p.out + O_SVS + b * 32768 + rem) = *(const f32x4*)(p.in[4] + b * 32768 + 2048 + rem);
        }
    }
}

__host__ __device__ inline bool phase_skipped(int ph) { if (ph == 0) return false; const int l = (ph - 1) / 10, s = (ph - 1) % 10; (void)l; (void)s; return false; }
__global__ void __launch_bounds__(NTHR, 2) mega(Params p) {
    extern __shared__ __attribute__((aligned(16))) unsigned char shm[];
    LAS unsigned char* lds = (LAS unsigned char*)shm;
    volatile LAS unsigned* st = (volatile LAS unsigned*)(lds + STAGE_BYTES);
    if (threadIdx.x < 4) st[threadIdx.x] = 0u;
    __syncthreads();
    XcdBarrier bar; bar.bar = (unsigned*)(p.ws + WS_BAR); bar.x = 0; bar.st = st;
    if (p.ph_hi - p.ph_lo > 1) bar = xcd_barrier_post((unsigned*)(p.ws + WS_BAR), st);
    for (int ph = p.ph_lo; ph < p.ph_hi; ++ph) {
        if (phase_skipped(ph)) continue;
        const int reps = (DUP_MASK != 0 && ((DUP_MASK >> (ph == 0 ? 10 : (ph - 1) % 10)) & 1)) ? 2 : 1;
        for (int rep = 0; rep < reps; ++rep) { run_phase(p, ph, lds, rep); if (DUP_BAR && rep + 1 < reps) xcd_barrier(bar); }
        if (ph + 1 < p.ph_hi) {
            if (ph == p.ph_lo) cg::this_grid().sync();
            else xcd_barrier(bar);
        }
    }
}

extern "C" void kernel_launch(void* const* d_in, const int* in_sizes, int n_in, void* d_out, int out_size, void* d_ws, size_t ws_size, hipStream_t stream) {
    static int grid = 0;
    if (grid == 0) {
        int dev = 0, cus = 0, per_cu = 0;
        hipGetDevice(&dev);
        hipDeviceGetAttribute(&cus, hipDeviceAttributeMultiprocessorCount, dev);
        hipFuncSetAttribute((const void*)mega, hipFuncAttributeMaxDynamicSharedMemorySize, LDS_BYTES);
        hipOccupancyMaxActiveBlocksPerMultiprocessor(&per_cu, (const void*)mega, NTHR, LDS_BYTES);
        if (per_cu < 1) per_cu = 1;
        grid = cus * 1;
        if (ws_size < WS_END) { fprintf(stderr, "kernel_launch: workspace too small (%zu < %zu)\n", ws_size, (size_t)WS_END); }
        (void)hipGetLastError();
    }
    Params p{};
    (void)hipMemsetAsync((unsigned char*)d_ws + WS_BAR, 0, 16384, stream);
    for (int i = 0; i < 29; ++i) p.in[i] = (const float*)d_in[i];
    p.out = (float*)d_out; p.ws = (unsigned char*)d_ws;
#if ONE_LAUNCH
    p.ph_lo = 0; p.ph_hi = NPHASE;
    void* args[] = {&p};
    hipError_t e = hipLaunchCooperativeKernel((const void*)mega, dim3(grid), dim3(NTHR), args, LDS_BYTES, stream);
    if (e != hipSuccess) fprintf(stderr, "cooperative launch failed: %s (grid %d)\n", hipGetErrorString(e), grid);
#else
    for (int ph = 0; ph < NPHASE; ++ph) {
        if (phase_skipped(ph)) continue;
        p.ph_lo = ph; p.ph_hi = ph + 1;
        hipLaunchKernelGGL(mega, dim3(grid), dim3(NTHR), LDS_BYTES, stream, p);
    }
#endif
}
```

```cpp
#include <hip/hip_runtime.h>
#include <hip/hip_cooperative_groups.h>
#include <cstdio>
namespace cg = cooperative_groups;

#ifndef ONE_LAUNCH
#define ONE_LAUNCH 1
#endif
#ifndef DUP_BAR
#define DUP_BAR 0
#endif
#ifndef DUP_MASK
#define DUP_MASK 0
#endif

#define LAS __attribute__((address_space(3)))
#define DI __device__ __forceinline__
typedef unsigned short u16;
typedef short bf16x8 __attribute__((ext_vector_type(8)));
typedef short s16x4 __attribute__((ext_vector_type(4)));
typedef float f32x4 __attribute__((ext_vector_type(4)));
typedef float f32x16 __attribute__((ext_vector_type(16)));
typedef unsigned u32x4 __attribute__((ext_vector_type(4)));
typedef unsigned u32x2 __attribute__((ext_vector_type(2)));

constexpr int D = 1024, FF = 2816, MP = 16384, MS = 1024, MT = MP + MS, SEQ = 8192;
constexpr int NTHR = 512, STAGE_BYTES = 131072, LDS_BYTES = STAGE_BYTES + 16;
constexpr int NPHASE = 41;
constexpr int NSPLIT = 4;

constexpr size_t O_Y = 0;
constexpr size_t O_CSP = (size_t)MT * D;
constexpr size_t O_CSS = O_CSP + 8192;
constexpr size_t O_SKP = O_CSS + 524288;
constexpr size_t O_SVP = O_SKP + 65536;
constexpr size_t O_SKS = O_SVP + 65536;
constexpr size_t O_SVS = O_SKS + 4194304;
constexpr size_t O_MKP = O_SVS + 4194304;
constexpr size_t O_MVP = O_MKP + 1048576;

constexpr size_t WS_X = 0;
constexpr size_t WS_XN = WS_X + (size_t)MT * D * 4;
constexpr size_t WS_XN2 = WS_XN + (size_t)MT * D * 2;
constexpr size_t WS_H = WS_XN2 + (size_t)MT * D * 2;
constexpr size_t WS_Z = WS_H + (size_t)MT * FF * 2;
constexpr size_t WS_Y = WS_Z + (size_t)MT * 3584 * 2;
constexpr size_t WS_KVB = WS_Y + (size_t)MT * 1536 * 2;
constexpr size_t WS_MEMN = WS_KVB + (size_t)MT * 512 * 2;
constexpr size_t WS_MEMKV = WS_MEMN + (size_t)4 * 512 * 1024 * 2;
constexpr size_t WS_W = WS_MEMKV + (size_t)4 * 512 * 1024 * 2;
constexpr size_t SZ_WGU = (size_t)5632 * 1024 * 2, SZ_WD = (size_t)1024 * 2816 * 2, SZ_WINA = (size_t)3584 * 1024 * 2, SZ_WINB = (size_t)1536 * 1024 * 2,
                 SZ_WOUT = (size_t)1024 * 1536 * 2, SZ_WKV = (size_t)512 * 1024 * 2, SZ_WMEM = (size_t)1024 * 1024 * 2;
constexpr size_t WS_WGU1 = WS_W, WS_WD1 = WS_WGU1 + 4 * SZ_WGU, WS_WGU2 = WS_WD1 + 4 * SZ_WD, WS_WD2 = WS_WGU2 + 4 * SZ_WGU, WS_WMEM = WS_WD2 + 4 * SZ_WD,
                 WS_WINA = WS_WMEM + 4 * SZ_WMEM, WS_WOUTA = WS_WINA + 2 * SZ_WINA, WS_WINB = WS_WOUTA + 2 * SZ_WOUT, WS_WOUTB = WS_WINB + 2 * SZ_WINB,
                 WS_WKV = WS_WOUTB + 2 * SZ_WOUT, WS_BAR = WS_WKV + SZ_WKV, WS_SSP = WS_BAR + 16384, WS_SSQ = WS_SSP + (size_t)13 * MT * 4, WS_P = WS_SSQ + (size_t)MT * 16 * 4,
                 WS_END = WS_P + (size_t)NSPLIT * MS * D * 4;

struct Params {
    const float* in[29];
    float* out;
    unsigned char* ws;
    int ph_lo, ph_hi;
};

DI unsigned cvt_pk_bf16(float lo, float hi) { unsigned r; asm("v_cvt_pk_bf16_f32 %0, %1, %2" : "=v"(r) : "v"(lo), "v"(hi)); return r; }
DI float bf_lo(unsigned w) { return __uint_as_float(w << 16); }
DI float bf_hi(unsigned w) { return __uint_as_float(w & 0xffff0000u); }
DI float wave_sum(float v) {
#pragma unroll
    for (int o = 32; o >= 1; o >>= 1) v += __shfl_xor(v, o);
    return v;
}
DI int opaque_tid() { int t = threadIdx.x; asm volatile("" : "+v"(t)); return t; }
DI u32x4 pack8(f32x4 a, f32x4 b) { u32x4 w; w.x = cvt_pk_bf16(a[0], a[1]); w.y = cvt_pk_bf16(a[2], a[3]); w.z = cvt_pk_bf16(b[0], b[1]); w.w = cvt_pk_bf16(b[2], b[3]); return w; }
DI float silu_f(float x) { return x * __builtin_amdgcn_rcpf(1.0f + __expf(-x)); }

#define XB_TMO      128
#define XB_XCNT(j)  (256  + 64 * (j))
#define XB_XSUB(j)  (1280 + 64 * (j))
#define XB_XGEN(j)  (2304 + 64 * (j))
#define XB_TOP      3328
#define XB_TOPGEN   3392
#define XCD_BAR_WORDS 3456
#define XB_SPIN_CAP (1u << 22)
DI unsigned xb_ld(unsigned* p)              { return __hip_atomic_load(p, __ATOMIC_RELAXED, __HIP_MEMORY_SCOPE_AGENT); }
DI unsigned xb_add(unsigned* p, unsigned v) { return __hip_atomic_fetch_add(p, v, __ATOMIC_RELAXED, __HIP_MEMORY_SCOPE_AGENT); }
DI unsigned xb_xcc_id() { return (unsigned)__builtin_amdgcn_s_getreg((3 << 11) | 20) & 0xFu; }
#define XB_SPIN(cond, bar) do { unsigned _sp = 0; while (cond) { __builtin_amdgcn_s_sleep(1); \
    if ((++_sp & 255u) == 0u) { if (xb_ld(&(bar)[XB_TMO])) break; if (_sp > XB_SPIN_CAP) { atomicAdd(&(bar)[XB_TMO], 1u); break; } } } } while (0)
struct XcdBarrier { unsigned* bar; unsigned x; volatile LAS unsigned* st; };
DI XcdBarrier xcd_barrier_post(unsigned* bar, volatile LAS unsigned* st) {
    XcdBarrier b; b.bar = bar; b.x = xb_xcc_id(); b.st = st;
    if (threadIdx.x == 0) (void)xb_add(&bar[XB_XCNT(b.x)], 1u);
    return b;
}
DI void xcd_barrier_complete(unsigned* bar, unsigned x, unsigned& nloc, unsigned& nx) {
    const unsigned G = gridDim.x * gridDim.y * gridDim.z;
    unsigned sum, cnt, mine, sp = 0u;
    for (;;) {
        sum = 0u; cnt = 0u; mine = 0u;
#pragma unroll
        for (unsigned j = 0; j < 16; ++j) { const unsigned c = xb_ld(&bar[XB_XCNT(j)]); sum += c; cnt += (c > 0u) ? 1u : 0u; mine = (j == x) ? c : mine; }
        if (sum == G) break;
        __builtin_amdgcn_s_sleep(1);
        if ((++sp & 255u) == 0u) { if (xb_ld(&bar[XB_TMO])) break; if (sp > XB_SPIN_CAP) { atomicAdd(&bar[XB_TMO], 1u); break; } }
    }
    nloc = mine > 0u ? mine : 1u; nx = cnt > 0u ? cnt : 1u;
}
DI void xcd_barrier(const XcdBarrier& b) {
    asm volatile("s_waitcnt vmcnt(0)" ::: "memory");
    __syncthreads();
    if (threadIdx.x == 0) {
        unsigned* bar = b.bar;
        __builtin_amdgcn_s_waitcnt(0);
        unsigned nloc = b.st[0], nx = b.st[1];
        if (nloc == 0u) { xcd_barrier_complete(bar, b.x, nloc, nx); b.st[0] = nloc; b.st[1] = nx; }
        const unsigned old = xb_add(&bar[XB_XSUB(b.x)], 1u);
        const unsigned gen = old / nloc;
        if (old + 1u == (gen + 1u) * nloc) {
            __builtin_amdgcn_fence(__ATOMIC_RELEASE, "agent");
            asm volatile("s_waitcnt vmcnt(0)" ::: "memory");
            const unsigned og = xb_add(&bar[XB_TOP], 1u);
            const unsigned tg = og / nx;
            if (og + 1u == (tg + 1u) * nx) xb_add(&bar[XB_TOPGEN], 1u);
            else XB_SPIN(xb_ld(&bar[XB_TOPGEN]) == tg, bar);
            __builtin_amdgcn_fence(__ATOMIC_ACQUIRE, "agent");
            asm volatile("s_waitcnt vmcnt(0)" ::: "memory");
        } else {
            XB_SPIN(xb_ld(&bar[XB_TOPGEN]) == gen, bar);
            __builtin_amdgcn_fence(__ATOMIC_ACQUIRE, "agent");
            asm volatile("s_waitcnt vmcnt(0)" ::: "memory");
        }
    }
    __syncthreads();
}

namespace pg8 {
constexpr int BM = 256, BK = 64, HALF = 128, HTB = HALF * BK * 2, NXCD = 8, WGM = 4;
DI int lds_byte(int r, int c) { const int st = (r >> 4) * 2 + (c >> 5), rr = r & 15, cc = c & 31, ob = rr * 64 + cc * 2; return st * 1024 + (ob ^ (((ob >> 9) & 1) << 5)); }
DI void stage_rc(int b, int& R, int& C) { const int st = b / 1024, sb = b % 1024, swz = sb ^ (((sb >> 9) & 1) << 5); R = (st >> 1) * 16 + swz / 64; C = (st & 1) * 32 + (swz % 64) / 2; }
DI int perm32(int rho) { const int n = rho >> 4, i = rho & 15; return 8 * (i >> 2) + 4 * n + (i & 3); }
struct Unit { int pm, pn, k0, nt, part; };
struct Gemm { const u16* A; const u16* Bt; int M, N, K; };
struct StaticOrder {
    int nM, nN, nwg, G, c, ntk, ns, nMall;
    DI void init(int M, int N, int K, int G_, int c_, int ns_) { nMall = M / BM; nM = ns_ ? MP / BM : nMall; nN = N / BM; nwg = nM * nN; G = G_; c = c_; ntk = K / BK; ns = ns_; }
    DI Unit next(int i) const {
        Unit u; u.pm = 0; u.pn = 0; u.k0 = 0; u.nt = 0; u.part = -1;
        const long L = (long)i * G + c; if (c < 0) return u;
        if (L >= nwg) {
            if (ns == 0) return u;
            const int j = (int)(L - nwg); if (j >= (nMall - nM) * nN * ns) return u;
            const int tile = j / ns, sp = j % ns, pairs = ntk >> 1, base = pairs / ns, rem = pairs % ns;
            u.pm = nM + tile / nN; u.pn = tile % nN; u.part = sp;
            u.k0 = 2 * (sp * base + (sp < rem ? sp : rem)); u.nt = 2 * (base + (sp < rem ? 1 : 0));
            return u;
        }
        int wgid = (int)L; { const int q = nwg / NXCD, r = nwg % NXCD, xcd = wgid % NXCD, off = wgid / NXCD; wgid = (xcd < r ? xcd * (q + 1) : r * (q + 1) + (xcd - r) * q) + off; }
        const int nig = WGM * nN, gid = wgid / nig, fm = gid * WGM, gsz = (nM - fm) < WGM ? (nM - fm) : WGM;
        u.pm = fm + ((wgid % nig) % gsz); u.pn = (wgid % nig) / gsz; u.nt = ntk; return u;
    }
};

template <class Epi>
DI void gemm_phase(LAS unsigned char* lds, const Gemm g, const StaticOrder& S, const Epi& E) {
    const int tid = opaque_tid(), wid = __builtin_amdgcn_readfirstlane(tid >> 6), lane = tid & 63, wr = wid >> 2, wc = wid & 3, fr = lane & 15, fq = lane >> 4;
    const int K = g.K;
    unsigned voffA[2], voffB[2];
#pragma unroll
    for (int i = 0; i < 2; ++i) { int R, C; stage_rc(tid * 16 + i * 8192, R, C); const int Rb = Epi::PERM ? ((R & ~31) + perm32(R & 31)) : R;
        voffA[i] = (unsigned)(R * K + C) * 2u; voffB[i] = (unsigned)(Rb * K + C) * 2u; }
    const size_t kstep = (size_t)(BK * 2);
    const size_t hstep = (size_t)HALF * K * 2;
    const size_t tstep = 2 * hstep;
    const unsigned ldsw = (unsigned)wid * 1024u;
    const int aoff = lds_byte(wr * 64 + fr, fq * 8), boff = lds_byte(wc * 32 + fr, fq * 8);
#define PG8_SA(b, h) (((b) * 2 + (h)) * HTB)
#define PG8_SB(b, h) ((4 + (b) * 2 + (h)) * HTB)
#define PG8_STAGE(bufoff, gbase, voff) do { _Pragma("unroll") for (int _i = 0; _i < 2; ++_i) \
        __builtin_amdgcn_global_load_lds((const unsigned*)((const char*)(gbase) + (voff)[_i]), (LAS unsigned*)(lds + (bufoff) + ldsw + _i * 8192), 16, 0, 0); } while (0)
#define PG8_LDA(dst, b, h) do { _Pragma("unroll") for (int m = 0; m < 4; ++m) _Pragma("unroll") for (int k = 0; k < 2; ++k) dst[m][k] = *(const LAS bf16x8*)(lds + PG8_SA(b, h) + aoff + m * 2048 + k * 1024); } while (0)
#define PG8_LDB(dst, b, h) do { _Pragma("unroll") for (int n = 0; n < 2; ++n) _Pragma("unroll") for (int k = 0; k < 2; ++k) dst[n][k] = *(const LAS bf16x8*)(lds + PG8_SB(b, h) + boff + n * 2048 + k * 1024); } while (0)
#define PG8_MMA(ai, bj, At, Bt) do { __builtin_amdgcn_s_setprio(1); _Pragma("unroll") for (int m = 0; m < 4; ++m) _Pragma("unroll") for (int n = 0; n < 2; ++n) _Pragma("unroll") for (int k = 0; k < 2; ++k) \
        acc[ai][bj][m][n] = __builtin_amdgcn_mfma_f32_16x16x32_bf16(Bt[n][k], At[m][k], acc[ai][bj][m][n], 0, 0, 0); __builtin_amdgcn_s_setprio(0); } while (0)
#define PG8_WAIT_V(n) asm volatile("s_waitcnt vmcnt(" #n ")" ::: "memory")
#define PG8_WAIT_L(n) asm volatile("s_waitcnt lgkmcnt(" #n ")" ::: "memory")
#define PG8_BAR __builtin_amdgcn_s_barrier()
#define PG8_SCHED __builtin_amdgcn_sched_barrier(0)
    Unit cur = S.next(0), nxt; int ui = 0;
    if (cur.nt == 0) return;
    f32x4 acc[2][2][4][2];
#pragma unroll
    for (int a = 0; a < 2; ++a)
#pragma unroll
        for (int b = 0; b < 2; ++b)
#pragma unroll
            for (int m = 0; m < 4; ++m)
#pragma unroll
                for (int n = 0; n < 2; ++n) acc[a][b][m][n] = (f32x4){0.f, 0.f, 0.f, 0.f};
    bf16x8 At[4][2], B0[2][2], B1[2][2];
    const char* cA = (const char*)g.A + (size_t)cur.pm * tstep + (size_t)cur.k0 * kstep; const char* cB = (const char*)g.Bt + (size_t)cur.pn * tstep + (size_t)cur.k0 * kstep;
    float rsum[8];
#pragma unroll
    for (int k = 0; k < 8; ++k) rsum[k] = 0.f;
    E.load_rs(cur, wr, fr, rsum);
    PG8_STAGE(PG8_SB(0, 0), cB, voffB); PG8_STAGE(PG8_SB(0, 1), cB + hstep, voffB); PG8_STAGE(PG8_SA(0, 0), cA, voffA); PG8_STAGE(PG8_SA(0, 1), cA + hstep, voffA);
    if (wr == 1) PG8_BAR;
    PG8_WAIT_V(2); PG8_BAR;
    PG8_STAGE(PG8_SB(1, 0), cB + kstep, voffB); PG8_STAGE(PG8_SA(1, 0), cA + kstep, voffA); PG8_STAGE(PG8_SB(1, 1), cB + hstep + kstep, voffB);
    PG8_WAIT_V(6); PG8_BAR;
    for (;;) {
        nxt = S.next(ui + 1);
        const bool has_next = nxt.nt != 0;
        const char* nA = has_next ? (const char*)g.A + (size_t)nxt.pm * tstep + (size_t)nxt.k0 * kstep : cA; const char* nB = has_next ? (const char*)g.Bt + (size_t)nxt.pn * tstep + (size_t)nxt.k0 * kstep : cB;
        const int nt = cur.nt;
        for (int t = 0; t < nt; t += 2) {
            const bool last = (t == nt - 2);
            const char* a1 = cA + (size_t)(t + 1) * kstep;
            const char* a2 = last ? nA : cA + (size_t)(t + 2) * kstep; const char* b2 = last ? nB : cB + (size_t)(t + 2) * kstep;
            const char* a3 = a2 + kstep; const char* b3 = b2 + kstep;
            PG8_LDB(B0, 0, 0); PG8_LDB(B1, 0, 1); PG8_SCHED; PG8_LDA(At, 0, 0); PG8_STAGE(PG8_SA(1, 1), a1 + hstep, voffA);
            PG8_WAIT_V(8); PG8_WAIT_L(0); PG8_BAR; PG8_MMA(0, 0, At, B0); PG8_MMA(0, 1, At, B1); PG8_BAR; PG8_SCHED;
            PG8_LDA(At, 0, 1); PG8_STAGE(PG8_SB(0, 0), b2, voffB); PG8_STAGE(PG8_SB(0, 1), b2 + hstep, voffB); PG8_STAGE(PG8_SA(0, 0), a2, voffA);
            PG8_WAIT_V(8); PG8_WAIT_L(0); PG8_BAR; PG8_MMA(1, 0, At, B0); PG8_MMA(1, 1, At, B1); PG8_BAR; PG8_SCHED;
            PG8_LDB(B0, 1, 0); PG8_LDB(B1, 1, 1); PG8_SCHED; PG8_LDA(At, 1, 0); PG8_STAGE(PG8_SA(0, 1), a2 + hstep, voffA);
            PG8_WAIT_V(8); PG8_WAIT_L(0); PG8_BAR; PG8_MMA(0, 0, At, B0); PG8_MMA(0, 1, At, B1); PG8_BAR; PG8_SCHED;
            PG8_LDA(At, 1, 1); PG8_STAGE(PG8_SB(1, 0), b3, voffB); PG8_STAGE(PG8_SB(1, 1), b3 + hstep, voffB); PG8_STAGE(PG8_SA(1, 0), a3, voffA);
            PG8_WAIT_V(8); PG8_WAIT_L(0); PG8_BAR; PG8_MMA(1, 0, At, B0); PG8_MMA(1, 1, At, B1); PG8_BAR; PG8_SCHED;
        }
        if (wr == 0) PG8_BAR;
        E(acc, cur, wr, wc, fr, fq, rsum);
        if (!has_next) break;
        E.load_rs(nxt, wr, fr, rsum);
#pragma unroll
        for (int a = 0; a < 2; ++a)
#pragma unroll
            for (int b = 0; b < 2; ++b)
#pragma unroll
                for (int m = 0; m < 4; ++m)
#pragma unroll
                    for (int n = 0; n < 2; ++n) acc[a][b][m][n] = (f32x4){0.f, 0.f, 0.f, 0.f};
        cur = nxt; cA = nA; cB = nB; ++ui;
        if (wr == 1) PG8_BAR;
    }
    PG8_WAIT_V(0);
    PG8_BAR;
#undef PG8_SA
#undef PG8_SB
#undef PG8_STAGE
#undef PG8_LDA
#undef PG8_LDB
#undef PG8_MMA
#undef PG8_WAIT_V
#undef PG8_WAIT_L
#undef PG8_BAR
#undef PG8_SCHED
}
}
using pg8::Unit;

enum { EM_SWIGLU = 0, EM_RESID = 1, EM_BF16 = 2, EM_KV = 3, EM_MEMKV = 4, EM_WINA = 5 };
struct Epi {
    static constexpr bool PERM = true;
    int mode; u16* O; int ldc; float* F0; float* F1; float s;
    float* SSP;
    DI void load_rs(const Unit& u, int wr, int fr, float (&rsum)[8]) const {
        if (SSP && mode != EM_RESID) {
#pragma unroll
            for (int k = 0; k < 8; ++k) rsum[k] = SSP[u.pm * 256 + (k >> 2) * 128 + wr * 64 + (k & 3) * 16 + fr];
        }
    }
    DI float row_rs(float t) const { return SSP ? rsqrtf(t * (1.0f / D) + 1e-5f) : 1.0f; }
    DI void operator()(const f32x4 (&acc)[2][2][4][2], const Unit& u, int wr, int wc, int fr, int fq, const float (&rsum)[8]) const {
        const int row0 = u.pm * 256 + wr * 64 + fr, cin = wc * 32 + 8 * fq;
        if (mode == EM_SWIGLU) {
#pragma unroll
            for (int ai = 0; ai < 2; ++ai)
#pragma unroll
                for (int m = 0; m < 4; ++m) {
                    u16* rowp = O + (size_t)(row0 + ai * 128 + m * 16) * FF + u.pn * 128 + cin;
                    const float rs = row_rs(rsum[ai * 4 + m]);
                    const f32x4 g0 = acc[ai][0][m][0] * rs, g1 = acc[ai][0][m][1] * rs, u0 = acc[ai][1][m][0] * rs, u1 = acc[ai][1][m][1] * rs;
                    u32x4 w;
                    w.x = cvt_pk_bf16(silu_f(g0[0]) * u0[0], silu_f(g0[1]) * u0[1]); w.y = cvt_pk_bf16(silu_f(g0[2]) * u0[2], silu_f(g0[3]) * u0[3]);
                    w.z = cvt_pk_bf16(silu_f(g1[0]) * u1[0], silu_f(g1[1]) * u1[1]); w.w = cvt_pk_bf16(silu_f(g1[2]) * u1[2], silu_f(g1[3]) * u1[3]);
                    *(u32x4*)rowp = w;
                }
        } else if (mode == EM_WINA && u.pn >= 4 && u.pn < 12) {
#pragma unroll
            for (int ai = 0; ai < 2; ++ai)
#pragma unroll
                for (int m = 0; m < 4; ++m) {
                    u16* rowp = O + (size_t)(row0 + ai * 128 + m * 16) * 2560 + 1024 + (u.pn - 4) * 128 + cin;
                    const float rs = row_rs(rsum[ai * 4 + m]), rs2 = rs * rs;
                    const f32x4 u0 = acc[ai][0][m][0] * acc[ai][1][m][0] * rs2, u1 = acc[ai][0][m][1] * acc[ai][1][m][1] * rs2;
                    *(u32x4*)rowp = pack8(u0, u1);
                }
        } else if (mode == EM_RESID && u.part >= 0) {
#pragma unroll
            for (int ai = 0; ai < 2; ++ai)
#pragma unroll
                for (int m = 0; m < 4; ++m) {
                    float* rowp = F1 + ((size_t)u.part * MS + (row0 + ai * 128 + m * 16 - MP)) * D + u.pn * 256 + cin;
#pragma unroll
                    for (int bj = 0; bj < 2; ++bj) { f32x4* p0 = (f32x4*)(rowp + bj * 128); p0[0] = acc[ai][bj][m][0] * s; p0[1] = acc[ai][bj][m][1] * s; }
                }
        } else if (mode == EM_RESID) {
#pragma unroll
            for (int ai = 0; ai < 2; ++ai)
#pragma unroll
                for (int m = 0; m < 4; ++m) {
                    const int row = row0 + ai * 128 + m * 16;
                    u16* rowp = O + (size_t)row * D + u.pn * 256 + cin;
                    float ssq = 0.f;
#pragma unroll
                    for (int bj = 0; bj < 2; ++bj) {
                        const u32x4 xb = *(const u32x4*)(rowp + bj * 128);
                        const f32x4 x0 = (f32x4){bf_lo(xb.x), bf_hi(xb.x), bf_lo(xb.y), bf_hi(xb.y)} + acc[ai][bj][m][0] * s;
                        const f32x4 x1 = (f32x4){bf_lo(xb.z), bf_hi(xb.z), bf_lo(xb.w), bf_hi(xb.w)} + acc[ai][bj][m][1] * s;
                        *(u32x4*)(rowp + bj * 128) = pack8(x0, x1);
                        ssq += (x0[0] * x0[0] + x0[1] * x0[1]) + (x0[2] * x0[2] + x0[3] * x0[3]) + (x1[0] * x1[0] + x1[1] * x1[1]) + (x1[2] * x1[2] + x1[3] * x1[3]);
                    }
                    ssq += __shfl_xor(ssq, 16); ssq += __shfl_xor(ssq, 32);
                    if (fq == 0 && SSP) SSP[(size_t)row * 16 + u.pn * 4 + wc] = ssq;
                }
        } else {
#pragma unroll
            for (int ai = 0; ai < 2; ++ai)
#pragma unroll
                for (int m = 0; m < 4; ++m) {
                    const int r = row0 + ai * 128 + m * 16, col0 = (mode == EM_WINA && u.pn >= 12 ? u.pn - 4 : u.pn) * 256 + cin;
                    u16* rowp = O + (size_t)r * ldc + col0;
                    float* fo = nullptr;
                    if (mode == EM_KV) {
                        if (r < MP) { const int b = r >> 13, t = r & 8191; if (t >= SEQ - 128) fo = F0 + (u.pn ? O_SVP : O_SKP) + (size_t)(b * 128 + (t - (SEQ - 128))) * 256 + cin; }
                        else { const int rs = r - MP, b = rs >> 3, t = rs & 7; fo = F0 + (u.pn ? O_SVS : O_SKS) + (size_t)(b * 128 + 120 + t) * 256 + cin; }
                    } else if (mode == EM_MEMKV) {
                        fo = (col0 < 512 ? F0 + (size_t)r * 512 + col0 : F1 + (size_t)r * 512 + (col0 - 512));
                    }
                    const float rs = row_rs(rsum[ai * 4 + m]);
#pragma unroll
                    for (int bj = 0; bj < 2; ++bj) {
                        const f32x4 v0 = acc[ai][bj][m][0] * rs, v1 = acc[ai][bj][m][1] * rs;
                        u32x4 w; w.x = cvt_pk_bf16(v0[0], v0[1]); w.y = cvt_pk_bf16(v0[2], v0[3]); w.z = cvt_pk_bf16(v1[0], v1[1]); w.w = cvt_pk_bf16(v1[2], v1[3]);
                        *(u32x4*)(rowp + bj * 128) = w;
                        if (fo) { *(f32x4*)(fo + bj * 128) = v0; *(f32x4*)(fo + bj * 128 + 4) = v1; }
                    }
                }
        }
    }
};

DI void wt_tile(const float* __restrict__ src, u16* __restrict__ dst, int K, int N, int mode, int tile, LAS unsigned* T, const float* __restrict__ gain) {
    const int tid = opaque_tid();
    const int nN = N >> 6, nt = tile % nN, kt = tile / nN, k0 = kt * 128, n0 = nt * 64;
    int drow0;
    if (mode == 0) drow0 = n0;
    else if (mode == 3) {
        if (n0 < 1024 || n0 >= 3072) drow0 = n0;
        else if (n0 < 2048) { const int ci = n0 - 1024; drow0 = 1024 + (ci >> 7) * 256 + (ci & 127); }
        else { const int xi = n0 - 2048; drow0 = 1024 + (xi >> 7) * 256 + 128 + (xi & 127); }
    } else drow0 = (n0 >> 7) * 256 + (n0 & 127) + (mode == 2 ? 128 : 0);
#pragma unroll
    for (int pass = 0; pass < 2; ++pass) {
        const int kp = pass * 32 + (tid >> 4), nl = (tid & 15) * 4;
        const float* s = src + (size_t)(k0 + 2 * kp) * N + n0 + nl;
        const float ga = gain ? gain[k0 + 2 * kp] : 1.0f, gb = gain ? gain[k0 + 2 * kp + 1] : 1.0f;
        const f32x4 a = *(const f32x4*)s * ga, b = *(const f32x4*)(s + N) * gb;
        T[(nl + 0) * 65 + kp] = cvt_pk_bf16(a[0], b[0]); T[(nl + 1) * 65 + kp] = cvt_pk_bf16(a[1], b[1]);
        T[(nl + 2) * 65 + kp] = cvt_pk_bf16(a[2], b[2]); T[(nl + 3) * 65 + kp] = cvt_pk_bf16(a[3], b[3]);
    }
    __syncthreads();
    {
        const int n = tid >> 3, c = tid & 7;
        u32x4 w0, w1;
        w0.x = T[n * 65 + c * 8 + 0]; w0.y = T[n * 65 + c * 8 + 1]; w0.z = T[n * 65 + c * 8 + 2]; w0.w = T[n * 65 + c * 8 + 3];
        w1.x = T[n * 65 + c * 8 + 4]; w1.y = T[n * 65 + c * 8 + 5]; w1.z = T[n * 65 + c * 8 + 6]; w1.w = T[n * 65 + c * 8 + 7];
        u16* d = dst + (size_t)(drow0 + n) * K + k0 + c * 16;
        *(u32x4*)d = w0; *(u32x4*)(d + 8) = w1;
    }
    __syncthreads();
}
constexpr int WT_TILES = 11072;
DI void wt_dispatch(const Params& p, int idx, LAS unsigned* T) {
    const float* src; u16* dst; int K, N, mode = 0, tile; const float* gain = nullptr;
    unsigned char* ws = p.ws;
    if (idx < 8960) {
        const int l = idx / 2240, r = idx % 2240; int t = r / 352; if (t > 6) t = 6; tile = r - t * 352;
        if (t == 0) { src = p.in[9] + (size_t)l * D * FF; dst = (u16*)(ws + WS_WGU1 + l * SZ_WGU); K = D; N = FF; mode = 1; gain = p.in[8] + l * D; }
        else if (t == 1) { src = p.in[10] + (size_t)l * D * FF; dst = (u16*)(ws + WS_WGU1 + l * SZ_WGU); K = D; N = FF; mode = 2; gain = p.in[8] + l * D; }
        else if (t == 2) { src = p.in[11] + (size_t)l * D * FF; dst = (u16*)(ws + WS_WD1 + l * SZ_WD); K = FF; N = D; }
        else if (t == 3) { src = p.in[25] + (size_t)l * D * FF; dst = (u16*)(ws + WS_WGU2 + l * SZ_WGU); K = D; N = FF; mode = 1; gain = p.in[24] + l * D; }
        else if (t == 4) { src = p.in[26] + (size_t)l * D * FF; dst = (u16*)(ws + WS_WGU2 + l * SZ_WGU); K = D; N = FF; mode = 2; gain = p.in[24] + l * D; }
        else if (t == 5) { src = p.in[27] + (size_t)l * D * FF; dst = (u16*)(ws + WS_WD2 + l * SZ_WD); K = FF; N = D; }
        else { src = p.in[23] + (size_t)l * D * 1024; dst = (u16*)(ws + WS_WMEM + l * SZ_WMEM); K = D; N = 1024; }
    } else {
        int r = idx - 8960;
        if (r < 896) { const int j = r / 448; tile = r % 448; src = p.in[13] + (size_t)j * D * 3584; dst = (u16*)(ws + WS_WINA + j * SZ_WINA); K = D; N = 3584; mode = 3; gain = p.in[12] + j * D; }
        else if (r < 1280) { r -= 896; const int j = r / 192; tile = r % 192; src = p.in[15] + (size_t)j * 1536 * D; dst = (u16*)(ws + WS_WOUTA + j * SZ_WOUT); K = 1536; N = D; }
        else if (r < 1664) { r -= 1280; const int j = r / 192; tile = r % 192; src = p.in[18] + (size_t)j * D * 1536; dst = (u16*)(ws + WS_WINB + j * SZ_WINB); K = D; N = 1536; gain = p.in[12] + (2 + j) * D; }
        else if (r < 2048) { r -= 1664; const int j = r / 192; tile = r % 192; src = p.in[21] + (size_t)j * 1536 * D; dst = (u16*)(ws + WS_WOUTB + j * SZ_WOUT); K = 1536; N = D; }
        else { tile = r - 2048; src = p.in[17]; dst = (u16*)(ws + WS_WKV); K = D; N = 512; gain = p.in[16]; }
    }
    wt_tile(src, dst, K, N, mode, tile, T, gain);
}

DI void wt_deferred(const Params& p, int l, int s, LAS unsigned* T) {
    const int id = (int)blockIdx.x - 64, n = (int)gridDim.x - 64;
    if (id < 0 || n <= 0) return;
    int lo0 = 0, hi0 = 0, lo1 = 0, hi1 = 0;
    if (s == 1) {
        if (l < 2) { lo0 = 8960 + l * 448; hi0 = lo0 + 448; lo1 = 9856 + l * 192; hi1 = lo1 + 192; }
        else { lo0 = 10240 + (l - 2) * 192; hi0 = lo0 + 192; lo1 = 10624 + (l - 2) * 192; hi1 = lo1 + 192; }
    } else if (s == 5) { lo0 = l * 2240 + 1056; hi0 = lo0 + 1056; }
    else if (l < 3) { lo0 = (l + 1) * 2240; hi0 = lo0 + 1056; if (l == 1) { lo1 = 11008; hi1 = 11072; } }
    for (int idx = lo0 + id; idx < hi0; idx += n) wt_dispatch(p, idx, T);
    for (int idx = lo1 + id; idx < hi1; idx += n) wt_dispatch(p, idx, T);
}

DI void norm_phase(const u16* srcH, const float* srcA, int rowsA, const float* srcB, int nrows, const float* g1, u16* d1, const float* g2, u16* d2, float* ssout, float* fout) {
    const int tid = opaque_tid(), lane = tid & 63, wid = tid >> 6;
    for (int row = blockIdx.x * 8 + wid; row < nrows; row += gridDim.x * 8) {
        f32x4 v[4]; float ss = 0.f;
        if (srcH) {
#pragma unroll
            for (int i = 0; i < 4; ++i) { const u32x2 xb = *(const u32x2*)(srcH + (size_t)row * D + i * 256 + lane * 4); v[i] = (f32x4){bf_lo(xb.x), bf_hi(xb.x), bf_lo(xb.y), bf_hi(xb.y)}; }
        } else {
            const float* s = row < rowsA ? srcA + (size_t)row * D : srcB + (size_t)(row - rowsA) * D;
#pragma unroll
            for (int i = 0; i < 4; ++i) v[i] = *(const f32x4*)(s + i * 256 + lane * 4);
        }
#pragma unroll
        for (int i = 0; i < 4; ++i) ss += v[i][0] * v[i][0] + v[i][1] * v[i][1] + v[i][2] * v[i][2] + v[i][3] * v[i][3];
        ss = wave_sum(ss);
        const float r = rsqrtf(ss * (1.0f / D) + 1e-5f);
        if (ssout) {
            if (lane == 0) ssout[row] = ss;
#pragma unroll
            for (int i = 0; i < 4; ++i) { u32x2 w; w.x = cvt_pk_bf16(v[i][0], v[i][1]); w.y = cvt_pk_bf16(v[i][2], v[i][3]); *(u32x2*)(d1 + (size_t)row * D + i * 256 + lane * 4) = w; }
            continue;
        }
        if (d1) {
#pragma unroll
            for (int i = 0; i < 4; ++i) { const f32x4 g = *(const f32x4*)(g1 + i * 256 + lane * 4); u32x2 w; w.x = cvt_pk_bf16(v[i][0] * r * g[0], v[i][1] * r * g[1]); w.y = cvt_pk_bf16(v[i][2] * r * g[2], v[i][3] * r * g[3]);
                *(u32x2*)(d1 + (size_t)row * D + i * 256 + lane * 4) = w; }
        }
        if (d2) {
#pragma unroll
            for (int i = 0; i < 4; ++i) { const f32x4 g = *(const f32x4*)(g2 + i * 256 + lane * 4); u32x2 w; w.x = cvt_pk_bf16(v[i][0] * r * g[0], v[i][1] * r * g[1]); w.y = cvt_pk_bf16(v[i][2] * r * g[2], v[i][3] * r * g[3]);
                *(u32x2*)(d2 + (size_t)row * D + i * 256 + lane * 4) = w; }
        }
        if (fout) {
#pragma unroll
            for (int i = 0; i < 4; ++i) { const f32x4 g = *(const f32x4*)(g1 + i * 256 + lane * 4); *(f32x4*)(fout + (size_t)row * D + i * 256 + lane * 4) = v[i] * r * g; }
        }
    }
}

template <int HD> DI unsigned k_off(int key, int ch) { const int sw = (HD == 128) ? (key & 15) : ((key >> 1) & 7); return (unsigned)(key * (HD * 2) + ((ch ^ sw) << 4)); }
DI unsigned vt_off(int d, int key) { return (unsigned)(d * 512 + ((((key >> 2) ^ (d & 31))) << 3) + ((key & 3) << 1)); }
DI int crow(int r, int hi) { return (r & 3) + 8 * (r >> 2) + 4 * hi; }
#define MFMA32(a, b, c) __builtin_amdgcn_mfma_f32_32x32x16_bf16((a), (b), (c), 0, 0, 0)

template <int HD, int NKT, class SF>
DI void attn_core(const LAS unsigned char* Kl, const LAS unsigned char* Vl, int kt0, const bf16x8 (&qf)[HD / 16], const SF& sf, float sink, f32x16 (&o)[HD / 32], int lane) {
    const int l31 = lane & 31, half = lane >> 5;
    float m = sink, lsum = 0.f;
#pragma unroll
    for (int dt = 0; dt < HD / 32; ++dt)
#pragma unroll
        for (int r = 0; r < 16; ++r) o[dt][r] = 0.f;
#pragma nounroll
    for (int t = 0; t < NKT; ++t) {
        const int kt = kt0 + t;
        f32x16 st;
#pragma unroll
        for (int r = 0; r < 16; ++r) st[r] = 0.f;
        const int key = 32 * kt + l31;
#pragma unroll
        for (int ks = 0; ks < HD / 16; ++ks) {
            const bf16x8 a = *(const LAS bf16x8*)(Kl + k_off<HD>(key, 2 * ks + half));
            st = MFMA32(a, qf[ks], st);
        }
        float mc = -INFINITY;
#pragma unroll
        for (int r = 0; r < 16; ++r) { const float s = sf(st[r], 32 * kt + crow(r, half)); st[r] = s; mc = fmaxf(mc, s); }
        mc = fmaxf(mc, __shfl_xor(mc, 32));
        const float mn = fmaxf(m, mc);
        const float alpha = __expf(m - mn);
        m = mn;
        lsum *= alpha;
#pragma unroll
        for (int dt = 0; dt < HD / 32; ++dt)
#pragma unroll
            for (int r = 0; r < 16; ++r) o[dt][r] *= alpha;
#pragma unroll
        for (int r = 0; r < 16; ++r) { const float e = __expf(st[r] - mn); st[r] = e; lsum += e; }
#pragma unroll
        for (int k2 = 0; k2 < 2; ++k2) {
            u32x4 pw;
            pw.x = cvt_pk_bf16(st[8 * k2 + 0], st[8 * k2 + 1]); pw.y = cvt_pk_bf16(st[8 * k2 + 2], st[8 * k2 + 3]);
            pw.z = cvt_pk_bf16(st[8 * k2 + 4], st[8 * k2 + 5]); pw.w = cvt_pk_bf16(st[8 * k2 + 6], st[8 * k2 + 7]);
            const bf16x8 pb = __builtin_bit_cast(bf16x8, pw);
            const int kc = 2 * kt + k2;
#pragma unroll
            for (int dt = 0; dt < HD / 32; ++dt) {
                const int d = 32 * dt + l31;
                const s16x4 v0 = *(const LAS s16x4*)(Vl + d * 512 + (((4 * kc + half) ^ l31) << 3));
                const s16x4 v1 = *(const LAS s16x4*)(Vl + d * 512 + (((4 * kc + 2 + half) ^ l31) << 3));
                const bf16x8 a = __builtin_shufflevector(v0, v1, 0, 1, 2, 3, 4, 5, 6, 7);
                o[dt] = MFMA32(a, pb, o[dt]);
            }
        }
    }
    lsum += __shfl_xor(lsum, 32);
    const float inv = 1.0f / (lsum + __expf(sink - m));
#pragma unroll
    for (int dt = 0; dt < HD / 32; ++dt)
#pragma unroll
        for (int r = 0; r < 16; ++r) o[dt][r] *= inv;
}

template <int HD>
DI void attn_store(const f32x16 (&o)[HD / 32], u16* dstrow, int lane) {
    const int half = lane >> 5;
#pragma unroll
    for (int dt = 0; dt < HD / 32; ++dt)
#pragma unroll
        for (int rq = 0; rq < 4; ++rq) {
            u32x2 w; w.x = cvt_pk_bf16(o[dt][4 * rq + 0], o[dt][4 * rq + 1]); w.y = cvt_pk_bf16(o[dt][4 * rq + 2], o[dt][4 * rq + 3]);
            *(u32x2*)(dstrow + 32 * dt + 8 * rq + 4 * half) = w;
        }
}

DI void vt_scatter(LAS unsigned char* Vl, int key, int ch, u32x4 vv) {
#pragma unroll
    for (int j = 0; j < 8; ++j) {
        const unsigned w = (j >> 1) == 0 ? vv.x : ((j >> 1) == 1 ? vv.y : ((j >> 1) == 2 ? vv.z : vv.w));
        const u16 val = (u16)((j & 1) ? (w >> 16) : (w & 0xffffu));
        *(LAS u16*)(Vl + vt_off(ch * 8 + j, key)) = val;
    }
}

DI void memattn_item(int item, LAS unsigned char* lds, const u16* Z, int ldz, int qcol, const u16* memkv_l, const float* ck_l, const float* cv_l, u16* Y) {
    const int tid = opaque_tid(), wid = tid >> 6, lane = tid & 63, l31 = lane & 31, half = lane >> 5;
    LAS unsigned char* Kl = lds; LAS unsigned char* Vl = lds + 65536;
    const bool prompt = item < 256;
    int b, h, qt = 0;
    if (prompt) { b = item >> 7; h = (item >> 5) & 3; qt = item & 31; } else { const int it = item - 256; b = it >> 2; h = it & 3; }
    if (prompt) {
#pragma unroll 2
        for (int i = 0; i < 8; ++i) {
            const int idx = tid + 512 * i, key = idx >> 4, ch = idx & 15;
            const u16* src = memkv_l + (size_t)(b * 256 + key) * 1024 + h * 128 + ch * 8;
            const u32x4 kv = *(const u32x4*)src; const u32x4 vv = *(const u32x4*)(src + 512);
            *(LAS u32x4*)(Kl + k_off<128>(key, ch)) = kv;
            vt_scatter(Vl, key, ch, vv);
        }
    } else {
#pragma unroll 4
        for (int i = 0; i < 8; ++i) {
            const int idx = tid + 512 * i, key = idx >> 4, ch = idx & 15;
            const size_t so = ((size_t)(b * 256 + key) * 4 + h) * 128 + ch * 8;
            const f32x4 k0 = *(const f32x4*)(ck_l + so), k1 = *(const f32x4*)(ck_l + so + 4), v0 = *(const f32x4*)(cv_l + so), v1 = *(const f32x4*)(cv_l + so + 4);
            *(LAS u32x4*)(Kl + k_off<128>(key, ch)) = pack8(k0, k1);
            vt_scatter(Vl, key, ch, pack8(v0, v1));
        }
    }
    __syncthreads();
    if (prompt || wid == 0) {
        const int row = prompt ? (b * SEQ + qt * 256 + wid * 32 + l31) : (MP + b * 8 + (l31 & 7));
        bf16x8 qf[8];
        const u16* qp = Z + (size_t)row * ldz + qcol + h * 128 + 8 * half;
#pragma unroll
        for (int ks = 0; ks < 8; ++ks) qf[ks] = *(const bf16x8*)(qp + 16 * ks);
        f32x16 o[4];
        attn_core<128, 8>(Kl, Vl, 0, qf, [](float s, int) { return s * 0.08838834764831845f; }, -INFINITY, o, lane);
        if (prompt || l31 < 8) attn_store<128>(o, Y + (size_t)row * 1536 + 1024 + h * 128, lane);
    }
    __syncthreads();
}

DI int t5_bucket(int n) {
    if (n < 16) return n;
    int large = 16 + (int)(logf((float)n / 16.0f) / 2.0794415416798357f * 16.0f);
    return large < 31 ? large : 31;
}
DI void swa_item(int item, LAS unsigned char* lds, const u16* Z  , const u16* KVB, const float* cache_k, const float* cache_v, const float* rel_bias, const float* sinks_j, u16* Y) {
    const int tid = opaque_tid(), wid = tid >> 6, lane = tid & 63, l31 = lane & 31;
    LAS unsigned char* Kl = lds; LAS unsigned char* Vl = lds + 32768; LAS float* biasT = (LAS float*)(lds + 65536);
    const bool prompt = item < 512;
    int b, nb = 1, hkv;
    if (prompt) { b = item >> 8; nb = (item >> 2) & 63; hkv = item & 3; } else { const int it = item - 512; b = it >> 2; hkv = it & 3; }
    { const int g = tid >> 7, dist = tid & 127; biasT[tid] = rel_bias[t5_bucket(dist) * 16 + hkv * 4 + g]; }
    if (prompt) {
#pragma unroll 2
        for (int i = 0; i < 4; ++i) {
            const int idx = tid + 512 * i, key = idx >> 3, ch = idx & 7;
            u32x4 kv = (u32x4){0u, 0u, 0u, 0u}, vv = (u32x4){0u, 0u, 0u, 0u};
            if (nb > 0 || key >= 128) { const u16* src = KVB + (size_t)(b * SEQ + (nb - 1) * 128 + key) * 512 + hkv * 64 + ch * 8; kv = *(const u32x4*)src; vv = *(const u32x4*)(src + 256); }
            *(LAS u32x4*)(Kl + k_off<64>(key, ch)) = kv;
            vt_scatter(Vl, key, ch, vv);
        }
    } else {
#pragma nounroll
        for (int i = 0; i < 3; ++i) {
            const int idx = tid + 512 * i, key = idx >> 3, ch = idx & 7;
            if (key < 160) {
                u32x4 kv = (u32x4){0u, 0u, 0u, 0u}, vv = (u32x4){0u, 0u, 0u, 0u};
                if (key < 128) {
                    const size_t so = ((size_t)(b * 128 + key) * 4 + hkv) * 64 + ch * 8;
                    kv = pack8(*(const f32x4*)(cache_k + so), *(const f32x4*)(cache_k + so + 4));
                    vv = pack8(*(const f32x4*)(cache_v + so), *(const f32x4*)(cache_v + so + 4));
                } else if (key < 136) { const u16* src = KVB + (size_t)(MP + b * 8 + (key - 128)) * 512 + hkv * 64 + ch * 8; kv = *(const u32x4*)src; vv = *(const u32x4*)(src + 256); }
                *(LAS u32x4*)(Kl + k_off<64>(key, ch)) = kv;
                vt_scatter(Vl, key, ch, vv);
            }
        }
    }
    __syncthreads();
    const int ntask = prompt ? 2 : (wid == 0 ? 1 : 0);
    for (int task = 0; task < ntask; ++task) {
        int g, qi, row, kt0, jmin;
        if (prompt) { g = wid >> 1; qi = (wid & 1) * 64 + task * 32 + l31; row = b * SEQ + nb * 128 + qi; kt0 = (wid & 1) * 2 + task; jmin = nb > 0 ? 0 : 128; }
        else { g = l31 >> 3; qi = l31 & 7; row = MP + b * 8 + qi; kt0 = 0; jmin = 0; }
        const int head = hkv * 4 + g;
        bf16x8 qf[4];
        const u16* qp = Z + (size_t)row * 1536 + head * 64 + 8 * (lane >> 5);
#pragma unroll
        for (int ks = 0; ks < 4; ++ks) qf[ks] = *(const bf16x8*)(qp + 16 * ks);
        const float sink = sinks_j[head];
        f32x16 o[2];
        const LAS float* bt = biasT + g * 128;
        attn_core<64, 5>(Kl, Vl, kt0, qf, [=](float s, int j) { const int dist = 128 + qi - j; const bool ok = ((unsigned)dist < 128u) && (j >= jmin); return ok ? s * 0.125f + bt[dist & 127] : -INFINITY; }, sink, o, lane);
        attn_store<64>(o, Y + (size_t)row * 1536 + head * 64, lane);
    }
    __syncthreads();
}

DI void conv_item(int item, const u16* Z  , u16* Y, const float* convw, const float* state_l, float* csp_l, float* css_l) {
    const int tid = opaque_tid(), chunk = tid >> 7, c0 = (tid & 127) * 8;
    const int r0 = item * 32 + chunk * 8;
    const bool sample = r0 >= MP;
    float u1[8], u2[8], w0[8], w1[8], w2[8];
    {
        const f32x4 a0 = *(const f32x4*)(convw + c0), a1 = *(const f32x4*)(convw + c0 + 4), b0 = *(const f32x4*)(convw + D + c0), b1 = *(const f32x4*)(convw + D + c0 + 4),
                    d0 = *(const f32x4*)(convw + 2 * D + c0), d1 = *(const f32x4*)(convw + 2 * D + c0 + 4);
#pragma unroll
        for (int j = 0; j < 4; ++j) { w0[j] = a0[j]; w0[j + 4] = a1[j]; w1[j] = b0[j]; w1[j + 4] = b1[j]; w2[j] = d0[j]; w2[j + 4] = d1[j]; }
    }
    int bs = 0;
    if (!sample) {
        if ((r0 & (SEQ - 1)) == 0) {
#pragma unroll
            for (int j = 0; j < 8; ++j) { u1[j] = 0.f; u2[j] = 0.f; }
        } else {
            const u32x4 q2 = *(const u32x4*)(Z + (size_t)(r0 - 2) * 2560 + 1024 + c0), q1 = *(const u32x4*)(Z + (size_t)(r0 - 1) * 2560 + 1024 + c0);
            u2[0] = bf_lo(q2.x); u2[1] = bf_hi(q2.x); u2[2] = bf_lo(q2.y); u2[3] = bf_hi(q2.y); u2[4] = bf_lo(q2.z); u2[5] = bf_hi(q2.z); u2[6] = bf_lo(q2.w); u2[7] = bf_hi(q2.w);
            u1[0] = bf_lo(q1.x); u1[1] = bf_hi(q1.x); u1[2] = bf_lo(q1.y); u1[3] = bf_hi(q1.y); u1[4] = bf_lo(q1.z); u1[5] = bf_hi(q1.z); u1[6] = bf_lo(q1.w); u1[7] = bf_hi(q1.w);
        }
    } else {
        bs = (r0 - MP) >> 3;
        const float* s2 = state_l + (size_t)(bs * 2) * D + c0; const float* s1 = s2 + D;
        const f32x4 p0 = *(const f32x4*)s2, p1 = *(const f32x4*)(s2 + 4), q0 = *(const f32x4*)s1, q1 = *(const f32x4*)(s1 + 4);
#pragma unroll
        for (int j = 0; j < 4; ++j) { u2[j] = p0[j]; u2[j + 4] = p1[j]; u1[j] = q0[j]; u1[j + 4] = q1[j]; }
    }
#pragma unroll
    for (int i = 0; i < 8; ++i) {
        const u16* z = Z + (size_t)(r0 + i) * 2560 + c0;
        const u32x4 bg = *(const u32x4*)z, ug = *(const u32x4*)(z + 1024);
        float u0[8], bb[8];
        u0[0] = bf_lo(ug.x); u0[1] = bf_hi(ug.x); u0[2] = bf_lo(ug.y); u0[3] = bf_hi(ug.y); u0[4] = bf_lo(ug.z); u0[5] = bf_hi(ug.z); u0[6] = bf_lo(ug.w); u0[7] = bf_hi(ug.w);
        bb[0] = bf_lo(bg.x); bb[1] = bf_hi(bg.x); bb[2] = bf_lo(bg.y); bb[3] = bf_hi(bg.y); bb[4] = bf_lo(bg.z); bb[5] = bf_hi(bg.z); bb[6] = bf_lo(bg.w); bb[7] = bf_hi(bg.w);
        float y[8];
#pragma unroll
        for (int j = 0; j < 8; ++j) { y[j] = bb[j] * (w0[j] * u2[j] + w1[j] * u1[j] + w2[j] * u0[j]); u2[j] = u1[j]; u1[j] = u0[j]; }
        u32x4 w; w.x = cvt_pk_bf16(y[0], y[1]); w.y = cvt_pk_bf16(y[2], y[3]); w.z = cvt_pk_bf16(y[4], y[5]); w.w = cvt_pk_bf16(y[6], y[7]);
        *(u32x4*)(Y + (size_t)(r0 + i) * 1536 + c0) = w;
    }
    float* so = nullptr;
    if (!sample) { if ((r0 & (SEQ - 1)) == SEQ - 8) so = csp_l + (size_t)((r0 >> 13) * 2) * D + c0; }
    else so = css_l + (size_t)(bs * 2) * D + c0;
    if (so) {
        *(f32x4*)so = (f32x4){u2[0], u2[1], u2[2], u2[3]}; *(f32x4*)(so + 4) = (f32x4){u2[4], u2[5], u2[6], u2[7]};
        *(f32x4*)(so + D) = (f32x4){u1[0], u1[1], u1[2], u1[3]}; *(f32x4*)(so + D + 4) = (f32x4){u1[4], u1[5], u1[6], u1[7]};
    }
}

DI void resid_finalize(u16* XB, const float* P, float* ssw, const float* ssq) {
    const int tid = opaque_tid(), lane = tid & 63, wid = tid >> 6;
    for (int row = blockIdx.x * NTHR + tid; row < MP; row += gridDim.x * NTHR) {
        const f32x4* q = (const f32x4*)(ssq + (size_t)row * 16); const f32x4 a = q[0], b = q[1], c = q[2], d = q[3];
        ssw[row] = (((a[0] + a[1]) + (a[2] + a[3])) + ((b[0] + b[1]) + (b[2] + b[3]))) + (((c[0] + c[1]) + (c[2] + c[3])) + ((d[0] + d[1]) + (d[2] + d[3])));
    }
    for (int row = blockIdx.x * 8 + wid; row < MT; row += gridDim.x * 8) {
        if (row < MP) continue;
        u16* xr = XB + (size_t)row * D;
        float ss = 0.f;
#pragma unroll
        for (int i = 0; i < 4; ++i) {
            const u32x2 xb = *(const u32x2*)(xr + i * 256 + lane * 4);
            f32x4 v = (f32x4){bf_lo(xb.x), bf_hi(xb.x), bf_lo(xb.y), bf_hi(xb.y)};
#pragma unroll
            for (int sp = 0; sp < NSPLIT; ++sp) v = v + *(const f32x4*)(P + ((size_t)sp * MS + (row - MP)) * D + i * 256 + lane * 4);
            ss += v[0] * v[0] + v[1] * v[1] + v[2] * v[2] + v[3] * v[3];
            u32x2 w; w.x = cvt_pk_bf16(v[0], v[1]); w.y = cvt_pk_bf16(v[2], v[3]);
            *(u32x2*)(xr + i * 256 + lane * 4) = w;
        }
        ss = wave_sum(ss);
        if (lane == 0) ssw[row] = ss;
    }
}

struct GemmDesc { const u16* A; const u16* Bt; int M, N, K, G, c, ns; Epi E; };
DI bool make_gemm(const Params& p, int l, int s, int gi, GemmDesc& d) {
    unsigned char* ws = p.ws;
    const int G = gridDim.x, bid = blockIdx.x;
    u16* XN = (u16*)(ws + WS_XN); u16* H = (u16*)(ws + WS_H);
    d.M = MT; d.K = D; d.G = G; d.c = bid; d.ns = 0; d.E.O = nullptr; d.E.ldc = 0; d.E.F0 = nullptr; d.E.F1 = nullptr; d.E.s = 1.0f;
    d.E.SSP = nullptr;
    float* SSP = (float*)(ws + WS_SSP);
    const float* ssr = (s == 0) ? (l == 0 ? SSP + (size_t)12 * MT : SSP + (size_t)(3 * l - 1) * MT) : SSP + (size_t)(3 * l + 1) * MT;
    if (s == 0 || s == 7) {
        if (gi == 0) { d.A = XN; d.Bt = (const u16*)(ws + (s == 0 ? WS_WGU1 : WS_WGU2) + l * SZ_WGU); d.N = 5632; d.E.mode = EM_SWIGLU; d.E.O = H; d.E.SSP = (float*)ssr; return true; }
        if (gi == 1 && s == 0 && l == 0) {
            const int c = bid - (G - 32); const int ml = c >= 0 ? (c >> 3) : 0;
            d.A = (const u16*)(ws + WS_MEMN) + (size_t)ml * 512 * 1024; d.Bt = (const u16*)(ws + WS_WMEM + ml * SZ_WMEM); d.M = 512; d.N = 1024; d.G = 8; d.c = c >= 0 ? (c & 7) : -1;
            d.E.mode = EM_MEMKV; d.E.O = (u16*)(ws + WS_MEMKV) + (size_t)ml * 512 * 1024; d.E.ldc = 1024; d.E.F0 = p.out + O_MKP + (size_t)ml * 512 * 512; d.E.F1 = p.out + O_MVP + (size_t)ml * 512 * 512; return true; }
        if (gi == 1 && s == 0 && l == 2) {
            d.A = XN; d.Bt = (const u16*)(ws + WS_WKV); d.N = 512; d.E.mode = EM_KV; d.E.O = (u16*)(ws + WS_KVB); d.E.ldc = 512; d.E.F0 = p.out; d.E.SSP = SSP + (size_t)5 * MT; return true; }
        return false;
    }
    if (gi != 0) return false;
    if (s == 1 || s == 8) { d.A = H; d.K = FF; d.Bt = (const u16*)(ws + (s == 1 ? WS_WD1 : WS_WD2) + l * SZ_WD); d.N = D; d.E.mode = EM_RESID; d.E.O = XN; d.E.s = 0.5f; d.E.SSP = (float*)(ws + WS_SSQ); d.ns = NSPLIT; d.E.F1 = (float*)(ws + WS_P); return true; }
    if (s == 5) { d.A = (const u16*)(ws + WS_Y); d.K = 1536; d.Bt = (const u16*)(ws + (l < 2 ? WS_WOUTA + l * SZ_WOUT : WS_WOUTB + (l - 2) * SZ_WOUT)); d.N = D; d.E.mode = EM_RESID; d.E.O = XN; d.E.SSP = (float*)(ws + WS_SSQ); d.ns = NSPLIT; d.E.F1 = (float*)(ws + WS_P); return true; }
    if (s == 3) { const int N = l < 2 ? 3584 : 1536; d.A = XN; d.Bt = (const u16*)(ws + (l < 2 ? WS_WINA + l * SZ_WINA : WS_WINB + (l - 2) * SZ_WINB)); d.N = N; d.E.mode = l < 2 ? EM_WINA : EM_BF16; d.E.O = (u16*)(ws + WS_Z); d.E.ldc = l < 2 ? 2560 : N; d.E.SSP = SSP + (size_t)(3 * l) * MT; return true; }
    return false;
}

DI void run_phase(const Params& p, int ph, LAS unsigned char* lds, int rep) {
    unsigned char* ws = p.ws;
    u16* XN = (u16*)(ws + WS_XN);
    const int G = gridDim.x, bid = blockIdx.x;
    const int l = ph == 0 ? 0 : (ph - 1) / 10, s = ph == 0 ? -1 : (ph - 1) % 10;
    if (ph == 0) {
        for (int idx = bid; idx < 1056 + 4 * 128; idx += G) wt_dispatch(p, idx < 1056 ? idx : ((idx - 1056) >> 7) * 2240 + 2112 + ((idx - 1056) & 127), (LAS unsigned*)lds);
    }
    if (s == 2 || s == 6 || s == 9) {
        float* SSP = (float*)(ws + WS_SSP);
        resid_finalize(XN, (const float*)(ws + WS_P), SSP + (size_t)(3 * l + (s == 2 ? 0 : (s == 6 ? 1 : 2))) * MT, (const float*)(ws + WS_SSQ));
        if (!(s == 9 && l == 3)) return;
    }
    if (ph == 0 || (s == 9 && l == 3)) {
        for (int pass = 0; pass < (ph == 0 ? 3 : 1); ++pass) {
            const u16* srcH = nullptr; const float* srcA = nullptr; const float* srcB = nullptr; int rowsA = MT, nrows = MT; const float* g1 = nullptr; u16* d1 = XN; const float* g2 = nullptr; u16* d2 = nullptr; float* sso = nullptr; float* fo = nullptr;
            if (ph == 0) {
                if (pass < 2) { srcA = srcB = p.in[7]; rowsA = nrows = 512; g1 = p.in[22] + (2 * pass) * D; g2 = g1 + D; d1 = (u16*)(ws + WS_MEMN) + (size_t)(2 * pass) * 512 * 1024; d2 = d1 + 512 * 1024; }
                else { srcA = p.in[0]; srcB = p.in[1]; rowsA = MP; sso = (float*)(ws + WS_SSP) + (size_t)12 * MT; }
            } else { srcH = XN; g1 = p.in[28]; d1 = nullptr; fo = p.out + O_Y; }
            norm_phase(srcH, srcA, rowsA, srcB, nrows, g1, d1, g2, d2, sso, fo);
        }
        return;
    }
    if (s == 4) {
        u16* Z = (u16*)(ws + WS_Z); u16* Y = (u16*)(ws + WS_Y);
        const int ldz = l < 2 ? 2560 : 1536, qcol = l < 2 ? 2048 : 1024;
        const u16* memkv_l = (const u16*)(ws + WS_MEMKV) + (size_t)l * 512 * 1024;
        const float* ck_l = p.in[5] + (size_t)l * 128 * 256 * 512; const float* cv_l = p.in[6] + (size_t)l * 128 * 256 * 512;
        const int nitems = l < 2 ? 768 + 544 : 768 + 1024;
        const int nround = (nitems + G - 1) / G, shift = (bid % 3 == 0) ? 0 : (bid % 3 == 1 ? 1 : 3);
        for (int k = 0; k < nround; ++k) {
            const int it = bid + ((k + shift) % nround) * G;
            if (it >= nitems) continue;
            if (it < 768) memattn_item(it, lds, Z, ldz, qcol, memkv_l, ck_l, cv_l, Y);
            else if (l < 2) conv_item(it - 768, Z, Y, p.in[14] + (size_t)l * 3 * D, p.in[2] + (size_t)l * 128 * 2 * D, p.out + O_CSP + (size_t)l * 2 * 2 * D, p.out + O_CSS + (size_t)l * 128 * 2 * D);
            else swa_item(it - 768, lds, Z, (const u16*)(ws + WS_KVB), p.in[3], p.in[4], p.in[20], p.in[19] + (l - 2) * 16, Y);
        }
        return;
    }
    for (int gi = 0; gi < 2; ++gi) {
        GemmDesc d;
        if (!make_gemm(p, l, s, gi, d)) break;
        if (rep && d.E.mode == EM_RESID) { d.E.s = 0.f; d.E.SSP = nullptr; }
        pg8::Gemm g{d.A, d.Bt, d.M, d.N, d.K}; pg8::StaticOrder S; S.init(d.M, d.N, d.K, d.G, d.c, d.ns);
        pg8::gemm_phase(lds, g, S, d.E);
    }
    if (s == 1 || s == 5 || s == 8) wt_deferred(p, l, s, (LAS unsigned*)lds);
    if (s == 5 && l == 0 && (int)blockIdx.x >= 64) {
        const size_t n4 = (size_t)128 * 30720 / 4;
        for (size_t e = (size_t)(bid - 64) * NTHR + opaque_tid(); e < n4; e += (size_t)(G - 64) * NTHR) {
            const size_t f = e * 4, b = f / 30720, rem = f % 30720;
            *(f32x4*)(p.out + O_SKS + b * 32768 + rem) = *(const f32x4*)(p.in[3] + b * 32768 + 2048 + rem);
            *(f32x4*)(p.out + O_SVS + b * 32768 + rem) = *(const f32x4*)(p.in[4] + b * 32768 + 2048 + rem);
        }
    }
}

__host__ __device__ inline bool phase_skipped(int ph) { if (ph == 0) return false; const int l = (ph - 1) / 10, s = (ph - 1) % 10; (void)l; (void)s; return false; }
__global__ void __launch_bounds__(NTHR, 2) mega(Params p) {
    extern __shared__ __attribute__((aligned(16))) unsigned char shm[];
    LAS unsigned char* lds = (LAS unsigned char*)shm;
    volatile LAS unsigned* st = (volatile LAS unsigned*)(lds + STAGE_BYTES);
    if (threadIdx.x < 4) st[threadIdx.x] = 0u;
    __syncthreads();
    XcdBarrier bar; bar.bar = (unsigned*)(p.ws + WS_BAR); bar.x = 0; bar.st = st;
    if (p.ph_hi - p.ph_lo > 1) bar = xcd_barrier_post((unsigned*)(p.ws + WS_BAR), st);
    for (int ph = p.ph_lo; ph < p.ph_hi; ++ph) {
        if (phase_skipped(ph)) continue;
        const int reps = (DUP_MASK != 0 && ((DUP_MASK >> (ph == 0 ? 10 : (ph - 1) % 10)) & 1)) ? 2 : 1;
        for (int rep = 0; rep < reps; ++rep) { run_phase(p, ph, lds, rep); if (DUP_BAR && rep + 1 < reps) xcd_barrier(bar); }
        if (ph + 1 < p.ph_hi) {
            if (ph == p.ph_lo) cg::this_grid().sync();
            else xcd_barrier(bar);
        }
    }
}

extern "C" void kernel_launch(void* const* d_in, const int* in_sizes, int n_in, void* d_out, int out_size, void* d_ws, size_t ws_size, hipStream_t stream) {
    static int grid = 0;
    if (grid == 0) {
        int dev = 0, cus = 0, per_cu = 0;
        hipGetDevice(&dev);
        hipDeviceGetAttribute(&cus, hipDeviceAttributeMultiprocessorCount, dev);
        hipFuncSetAttribute((const void*)mega, hipFuncAttributeMaxDynamicSharedMemorySize, LDS_BYTES);
        hipOccupancyMaxActiveBlocksPerMultiprocessor(&per_cu, (const void*)mega, NTHR, LDS_BYTES);
        if (per_cu < 1) per_cu = 1;
        grid = cus * 1;
        if (ws_size < WS_END) { fprintf(stderr, "kernel_launch: workspace too small (%zu < %zu)\n", ws_size, (size_t)WS_END); }
        (void)hipGetLastError();
    }
    Params p{};
    (void)hipMemsetAsync((unsigned char*)d_ws + WS_BAR, 0, 16384, stream);
    for (int i = 0; i < 29; ++i) p.in[i] = (const float*)d_in[i];
    p.out = (float*)d_out; p.ws = (unsigned char*)d_ws;
#if ONE_LAUNCH
    p.ph_lo = 0; p.ph_hi = NPHASE;
    void* args[] = {&p};
    hipError_t e = hipLaunchCooperativeKernel((const void*)mega, dim3(grid), dim3(NTHR), args, LDS_BYTES, stream);
    if (e != hipSuccess) fprintf(stderr, "cooperative launch failed: %s (grid %d)\n", hipGetErrorString(e), grid);
#else
    for (int ph = 0; ph < NPHASE; ++ph) {
        if (phase_skipped(ph)) continue;
        p.ph_lo = ph; p.ph_hi = ph + 1;
        hipLaunchKernelGGL(mega, dim3(grid), dim3(NTHR), LDS_BYTES, stream, p);
    }
#endif
}
```

```cpp
#include <hip/hip_runtime.h>
#include <hip/hip_cooperative_groups.h>
#include <cstdio>
namespace cg = cooperative_groups;

#ifndef ONE_LAUNCH
#define ONE_LAUNCH 1
#endif
#ifndef DUP_BAR
#define DUP_BAR 0
#endif
#ifndef DUP_MASK
#define DUP_MASK 0
#endif

#define LAS __attribute__((address_space(3)))
#define DI __device__ __forceinline__
typedef unsigned short u16;
typedef short bf16x8 __attribute__((ext_vector_type(8)));
typedef short s16x4 __attribute__((ext_vector_type(4)));
typedef float f32x4 __attribute__((ext_vector_type(4)));
typedef float f32x16 __attribute__((ext_vector_type(16)));
typedef unsigned u32x4 __attribute__((ext_vector_type(4)));
typedef unsigned u32x2 __attribute__((ext_vector_type(2)));

constexpr int D = 1024, FF = 2816, MP = 16384, MS = 1024, MT = MP + MS, SEQ = 8192;
constexpr int NTHR = 512, STAGE_BYTES = 131072, LDS_BYTES = STAGE_BYTES + 16;
constexpr int NPHASE = 41;
constexpr int NSPLIT = 4;

constexpr size_t O_Y = 0;
constexpr size_t O_CSP = (size_t)MT * D;
constexpr size_t O_CSS = O_CSP + 8192;
constexpr size_t O_SKP = O_CSS + 524288;
constexpr size_t O_SVP = O_SKP + 65536;
constexpr size_t O_SKS = O_SVP + 65536;
constexpr size_t O_SVS = O_SKS + 4194304;
constexpr size_t O_MKP = O_SVS + 4194304;
constexpr size_t O_MVP = O_MKP + 1048576;

constexpr size_t WS_X = 0;
constexpr size_t WS_XN = WS_X + (size_t)MT * D * 4;
constexpr size_t WS_XN2 = WS_XN + (size_t)MT * D * 2;
constexpr size_t WS_H = WS_XN2 + (size_t)MT * D * 2;
constexpr size_t WS_Z = WS_H + (size_t)MT * FF * 2;
constexpr size_t WS_Y = WS_Z + (size_t)MT * 3584 * 2;
constexpr size_t WS_KVB = WS_Y + (size_t)MT * 1536 * 2;
constexpr size_t WS_MEMN = WS_KVB + (size_t)MT * 512 * 2;
constexpr size_t WS_MEMKV = WS_MEMN + (size_t)4 * 512 * 1024 * 2;
constexpr size_t WS_W = WS_MEMKV + (size_t)4 * 512 * 1024 * 2;
constexpr size_t SZ_WGU = (size_t)5632 * 1024 * 2, SZ_WD = (size_t)1024 * 2816 * 2, SZ_WINA = (size_t)3584 * 1024 * 2, SZ_WINB = (size_t)1536 * 1024 * 2,
                 SZ_WOUT = (size_t)1024 * 1536 * 2, SZ_WKV = (size_t)512 * 1024 * 2, SZ_WMEM = (size_t)1024 * 1024 * 2;
constexpr size_t WS_WGU1 = WS_W, WS_WD1 = WS_WGU1 + 4 * SZ_WGU, WS_WGU2 = WS_WD1 + 4 * SZ_WD, WS_WD2 = WS_WGU2 + 4 * SZ_WGU, WS_WMEM = WS_WD2 + 4 * SZ_WD,
                 WS_WINA = WS_WMEM + 4 * SZ_WMEM, WS_WOUTA = WS_WINA + 2 * SZ_WINA, WS_WINB = WS_WOUTA + 2 * SZ_WOUT, WS_WOUTB = WS_WINB + 2 * SZ_WINB,
                 WS_WKV = WS_WOUTB + 2 * SZ_WOUT, WS_BAR = WS_WKV + SZ_WKV, WS_SSP = WS_BAR + 16384, WS_SSQ = WS_SSP + (size_t)13 * MT * 4, WS_P = WS_SSQ + (size_t)MT * 16 * 4,
                 WS_END = WS_P + (size_t)NSPLIT * MS * D * 4;

struct Params {
    const float* in[29];
    float* out;
    unsigned char* ws;
    int ph_lo, ph_hi;
};

DI unsigned cvt_pk_bf16(float lo, float hi) { unsigned r; asm("v_cvt_pk_bf16_f32 %0, %1, %2" : "=v"(r) : "v"(lo), "v"(hi)); return r; }
DI float bf_lo(unsigned w) { return __uint_as_float(w << 16); }
DI float bf_hi(unsigned w) { return __uint_as_float(w & 0xffff0000u); }
DI float wave_sum(float v) {
#pragma unroll
    for (int o = 32; o >= 1; o >>= 1) v += __shfl_xor(v, o);
    return v;
}
DI int opaque_tid() { int t = threadIdx.x; asm volatile("" : "+v"(t)); return t; }
DI u32x4 pack8(f32x4 a, f32x4 b) { u32x4 w; w.x = cvt_pk_bf16(a[0], a[1]); w.y = cvt_pk_bf16(a[2], a[3]); w.z = cvt_pk_bf16(b[0], b[1]); w.w = cvt_pk_bf16(b[2], b[3]); return w; }
DI float silu_f(float x) { return x * __builtin_amdgcn_rcpf(1.0f + __expf(-x)); }

#define XB_TMO      128
#define XB_XCNT(j)  (256  + 64 * (j))
#define XB_XSUB(j)  (1280 + 64 * (j))
#define XB_XGEN(j)  (2304 + 64 * (j))
#define XB_TOP      3328
#define XB_TOPGEN   3392
#define XCD_BAR_WORDS 3456
#define XB_SPIN_CAP (1u << 22)
DI unsigned xb_ld(unsigned* p)              { return __hip_atomic_load(p, __ATOMIC_RELAXED, __HIP_MEMORY_SCOPE_AGENT); }
DI unsigned xb_add(unsigned* p, unsigned v) { return __hip_atomic_fetch_add(p, v, __ATOMIC_RELAXED, __HIP_MEMORY_SCOPE_AGENT); }
DI unsigned xb_xcc_id() { return (unsigned)__builtin_amdgcn_s_getreg((3 << 11) | 20) & 0xFu; }
#define XB_SPIN(cond, bar) do { unsigned _sp = 0; while (cond) { __builtin_amdgcn_s_sleep(1); \
    if ((++_sp & 255u) == 0u) { if (xb_ld(&(bar)[XB_TMO])) break; if (_sp > XB_SPIN_CAP) { atomicAdd(&(bar)[XB_TMO], 1u); break; } } } } while (0)
struct XcdBarrier { unsigned* bar; unsigned x; volatile LAS unsigned* st; };
DI XcdBarrier xcd_barrier_post(unsigned* bar, volatile LAS unsigned* st) {
    XcdBarrier b; b.bar = bar; b.x = xb_xcc_id(); b.st = st;
    if (threadIdx.x == 0) (void)xb_add(&bar[XB_XCNT(b.x)], 1u);
    return b;
}
DI void xcd_barrier_complete(unsigned* bar, unsigned x, unsigned& nloc, unsigned& nx) {
    const unsigned G = gridDim.x * gridDim.y * gridDim.z;
    unsigned sum, cnt, mine, sp = 0u;
    for (;;) {
        sum = 0u; cnt = 0u; mine = 0u;
#pragma unroll
        for (unsigned j = 0; j < 16; ++j) { const unsigned c = xb_ld(&bar[XB_XCNT(j)]); sum += c; cnt += (c > 0u) ? 1u : 0u; mine = (j == x) ? c : mine; }
        if (sum == G) break;
        __builtin_amdgcn_s_sleep(1);
        if ((++sp & 255u) == 0u) { if (xb_ld(&bar[XB_TMO])) break; if (sp > XB_SPIN_CAP) { atomicAdd(&bar[XB_TMO], 1u); break; } }
    }
    nloc = mine > 0u ? mine : 1u; nx = cnt > 0u ? cnt : 1u;
}
DI void xcd_barrier(const XcdBarrier& b) {
    asm volatile("s_waitcnt vmcnt(0)" ::: "memory");
    __syncthreads();
    if (threadIdx.x == 0) {
        unsigned* bar = b.bar;
        __builtin_amdgcn_s_waitcnt(0);
        unsigned nloc = b.st[0], nx = b.st[1];
        if (nloc == 0u) { xcd_barrier_complete(bar, b.x, nloc, nx); b.st[0] = nloc; b.st[1] = nx; }
        const unsigned old = xb_add(&bar[XB_XSUB(b.x)], 1u);
        const unsigned gen = old / nloc;
        if (old + 1u == (gen + 1u) * nloc) {
            __builtin_amdgcn_fence(__ATOMIC_RELEASE, "agent");
            asm volatile("s_waitcnt vmcnt(0)" ::: "memory");
            (void)xb_add(&bar[XB_TOP], 1u);
        }
        XB_SPIN(xb_ld(&bar[XB_TOP]) < (gen + 1u) * nx, bar);
        __builtin_amdgcn_fence(__ATOMIC_ACQUIRE, "agent");
        asm volatile("s_waitcnt vmcnt(0)" ::: "memory");
    }
    __syncthreads();
}

namespace pg8 {
constexpr int BM = 256, BK = 64, HALF = 128, HTB = HALF * BK * 2, NXCD = 8, WGM = 4;
DI int lds_byte(int r, int c) { const int st = (r >> 4) * 2 + (c >> 5), rr = r & 15, cc = c & 31, ob = rr * 64 + cc * 2; return st * 1024 + (ob ^ (((ob >> 9) & 1) << 5)); }
DI void stage_rc(int b, int& R, int& C) { const int st = b / 1024, sb = b % 1024, swz = sb ^ (((sb >> 9) & 1) << 5); R = (st >> 1) * 16 + swz / 64; C = (st & 1) * 32 + (swz % 64) / 2; }
DI int perm32(int rho) { const int n = rho >> 4, i = rho & 15; return 8 * (i >> 2) + 4 * n + (i & 3); }
struct Unit { int pm, pn, k0, nt, part; };
struct Gemm { const u16* A; const u16* Bt; int M, N, K; };
struct StaticOrder {
    int nM, nN, nwg, G, c, ntk, ns, nMall;
    DI void init(int M, int N, int K, int G_, int c_, int ns_) { nMall = M / BM; nM = ns_ ? MP / BM : nMall; nN = N / BM; nwg = nM * nN; G = G_; c = c_; ntk = K / BK; ns = ns_; }
    DI Unit next(int i) const {
        Unit u; u.pm = 0; u.pn = 0; u.k0 = 0; u.nt = 0; u.part = -1;
        const long L = (long)i * G + c; if (c < 0) return u;
        if (L >= nwg) {
            if (ns == 0) return u;
            const int j = (int)(L - nwg); if (j >= (nMall - nM) * nN * ns) return u;
            const int tile = j / ns, sp = j % ns, pairs = ntk >> 1, base = pairs / ns, rem = pairs % ns;
            u.pm = nM + tile / nN; u.pn = tile % nN; u.part = sp;
            u.k0 = 2 * (sp * base + (sp < rem ? sp : rem)); u.nt = 2 * (base + (sp < rem ? 1 : 0));
            return u;
        }
        int wgid = (int)L; { const int q = nwg / NXCD, r = nwg % NXCD, xcd = wgid % NXCD, off = wgid / NXCD; wgid = (xcd < r ? xcd * (q + 1) : r * (q + 1) + (xcd - r) * q) + off; }
        const int nig = WGM * nN, gid = wgid / nig, fm = gid * WGM, gsz = (nM - fm) < WGM ? (nM - fm) : WGM;
        u.pm = fm + ((wgid % nig) % gsz); u.pn = (wgid % nig) / gsz; u.nt = ntk; return u;
    }
};

template <class Epi>
DI void gemm_phase(LAS unsigned char* lds, const Gemm g, const StaticOrder& S, const Epi& E) {
    const int tid = opaque_tid(), wid = __builtin_amdgcn_readfirstlane(tid >> 6), lane = tid & 63, wr = wid >> 2, wc = wid & 3, fr = lane & 15, fq = lane >> 4;
    const int K = g.K;
    unsigned voffA[2], voffB[2];
#pragma unroll
    for (int i = 0; i < 2; ++i) { int R, C; stage_rc(tid * 16 + i * 8192, R, C); const int Rb = Epi::PERM ? ((R & ~31) + perm32(R & 31)) : R;
        voffA[i] = (unsigned)(R * K + C) * 2u; voffB[i] = (unsigned)(Rb * K + C) * 2u; }
    const size_t kstep = (size_t)(BK * 2);
    const size_t hstep = (size_t)HALF * K * 2;
    const size_t tstep = 2 * hstep;
    const unsigned ldsw = (unsigned)wid * 1024u;
    const int aoff = lds_byte(wr * 64 + fr, fq * 8), boff = lds_byte(wc * 32 + fr, fq * 8);
#define PG8_SA(b, h) (((b) * 2 + (h)) * HTB)
#define PG8_SB(b, h) ((4 + (b) * 2 + (h)) * HTB)
#define PG8_STAGE(bufoff, gbase, voff) do { _Pragma("unroll") for (int _i = 0; _i < 2; ++_i) \
        __builtin_amdgcn_global_load_lds((const unsigned*)((const char*)(gbase) + (voff)[_i]), (LAS unsigned*)(lds + (bufoff) + ldsw + _i * 8192), 16, 0, 0); } while (0)
#define PG8_LDA(dst, b, h) do { _Pragma("unroll") for (int m = 0; m < 4; ++m) _Pragma("unroll") for (int k = 0; k < 2; ++k) dst[m][k] = *(const LAS bf16x8*)(lds + PG8_SA(b, h) + aoff + m * 2048 + k * 1024); } while (0)
#define PG8_LDB(dst, b, h) do { _Pragma("unroll") for (int n = 0; n < 2; ++n) _Pragma("unroll") for (int k = 0; k < 2; ++k) dst[n][k] = *(const LAS bf16x8*)(lds + PG8_SB(b, h) + boff + n * 2048 + k * 1024); } while (0)
#define PG8_MMA(ai, bj, At, Bt) do { __builtin_amdgcn_s_setprio(1); _Pragma("unroll") for (int m = 0; m < 4; ++m) _Pragma("unroll") for (int n = 0; n < 2; ++n) _Pragma("unroll") for (int k = 0; k < 2; ++k) \
        acc[ai][bj][m][n] = __builtin_amdgcn_mfma_f32_16x16x32_bf16(Bt[n][k], At[m][k], acc[ai][bj][m][n], 0, 0, 0); __builtin_amdgcn_s_setprio(0); } while (0)
#define PG8_WAIT_V(n) asm volatile("s_waitcnt vmcnt(" #n ")" ::: "memory")
#define PG8_WAIT_L(n) asm volatile("s_waitcnt lgkmcnt(" #n ")" ::: "memory")
#define PG8_BAR __builtin_amdgcn_s_barrier()
#define PG8_SCHED __builtin_amdgcn_sched_barrier(0)
    Unit cur = S.next(0), nxt; int ui = 0;
    if (cur.nt == 0) return;
    f32x4 acc[2][2][4][2];
#pragma unroll
    for (int a = 0; a < 2; ++a)
#pragma unroll
        for (int b = 0; b < 2; ++b)
#pragma unroll
            for (int m = 0; m < 4; ++m)
#pragma unroll
                for (int n = 0; n < 2; ++n) acc[a][b][m][n] = (f32x4){0.f, 0.f, 0.f, 0.f};
    bf16x8 At[4][2], B0[2][2], B1[2][2];
    const char* cA = (const char*)g.A + (size_t)cur.pm * tstep + (size_t)cur.k0 * kstep; const char* cB = (const char*)g.Bt + (size_t)cur.pn * tstep + (size_t)cur.k0 * kstep;
    float rsum[8];
#pragma unroll
    for (int k = 0; k < 8; ++k) rsum[k] = 0.f;
    E.load_rs(cur, wr, fr, rsum);
    PG8_STAGE(PG8_SB(0, 0), cB, voffB); PG8_STAGE(PG8_SB(0, 1), cB + hstep, voffB); PG8_STAGE(PG8_SA(0, 0), cA, voffA); PG8_STAGE(PG8_SA(0, 1), cA + hstep, voffA);
    if (wr == 1) PG8_BAR;
    PG8_WAIT_V(2); PG8_BAR;
    PG8_STAGE(PG8_SB(1, 0), cB + kstep, voffB); PG8_STAGE(PG8_SA(1, 0), cA + kstep, voffA); PG8_STAGE(PG8_SB(1, 1), cB + hstep + kstep, voffB);
    PG8_WAIT_V(6); PG8_BAR;
    for (;;) {
        nxt = S.next(ui + 1);
        const bool has_next = nxt.nt != 0;
        const char* nA = has_next ? (const char*)g.A + (size_t)nxt.pm * tstep + (size_t)nxt.k0 * kstep : cA; const char* nB = has_next ? (const char*)g.Bt + (size_t)nxt.pn * tstep + (size_t)nxt.k0 * kstep : cB;
        const int nt = cur.nt;
        for (int t = 0; t < nt; t += 2) {
            const bool last = (t == nt - 2);
            const char* a1 = cA + (size_t)(t + 1) * kstep;
            const char* a2 = last ? nA : cA + (size_t)(t + 2) * kstep; const char* b2 = last ? nB : cB + (size_t)(t + 2) * kstep;
            const char* a3 = a2 + kstep; const char* b3 = b2 + kstep;
            PG8_LDB(B0, 0, 0); PG8_LDB(B1, 0, 1); PG8_SCHED; PG8_LDA(At, 0, 0); PG8_STAGE(PG8_SA(1, 1), a1 + hstep, voffA);
            PG8_WAIT_V(8); PG8_WAIT_L(0); PG8_BAR; PG8_MMA(0, 0, At, B0); PG8_MMA(0, 1, At, B1); PG8_BAR; PG8_SCHED;
            PG8_LDA(At, 0, 1); PG8_STAGE(PG8_SB(0, 0), b2, voffB); PG8_STAGE(PG8_SB(0, 1), b2 + hstep, voffB); PG8_STAGE(PG8_SA(0, 0), a2, voffA);
            PG8_WAIT_V(8); PG8_WAIT_L(0); PG8_BAR; PG8_MMA(1, 0, At, B0); PG8_MMA(1, 1, At, B1); PG8_BAR; PG8_SCHED;
            PG8_LDB(B0, 1, 0); PG8_LDB(B1, 1, 1); PG8_SCHED; PG8_LDA(At, 1, 0); PG8_STAGE(PG8_SA(0, 1), a2 + hstep, voffA);
            PG8_WAIT_V(8); PG8_WAIT_L(0); PG8_BAR; PG8_MMA(0, 0, At, B0); PG8_MMA(0, 1, At, B1); PG8_BAR; PG8_SCHED;
            PG8_LDA(At, 1, 1); PG8_STAGE(PG8_SB(1, 0), b3, voffB); PG8_STAGE(PG8_SB(1, 1), b3 + hstep, voffB); PG8_STAGE(PG8_SA(1, 0), a3, voffA);
            PG8_WAIT_V(8); PG8_WAIT_L(0); PG8_BAR; PG8_MMA(1, 0, At, B0); PG8_MMA(1, 1, At, B1); PG8_BAR; PG8_SCHED;
        }
        if (wr == 0) PG8_BAR;
        E(acc, cur, wr, wc, fr, fq, rsum);
        if (!has_next) break;
        E.load_rs(nxt, wr, fr, rsum);
#pragma unroll
        for (int a = 0; a < 2; ++a)
#pragma unroll
            for (int b = 0; b < 2; ++b)
#pragma unroll
                for (int m = 0; m < 4; ++m)
#pragma unroll
                    for (int n = 0; n < 2; ++n) acc[a][b][m][n] = (f32x4){0.f, 0.f, 0.f, 0.f};
        cur = nxt; cA = nA; cB = nB; ++ui;
        if (wr == 1) PG8_BAR;
    }
    PG8_WAIT_V(0);
    PG8_BAR;
#undef PG8_SA
#undef PG8_SB
#undef PG8_STAGE
#undef PG8_LDA
#undef PG8_LDB
#undef PG8_MMA
#undef PG8_WAIT_V
#undef PG8_WAIT_L
#undef PG8_BAR
#undef PG8_SCHED
}
}
using pg8::Unit;

enum { EM_SWIGLU = 0, EM_RESID = 1, EM_BF16 = 2, EM_KV = 3, EM_MEMKV = 4, EM_WINA = 5 };
struct Epi {
    static constexpr bool PERM = true;
    int mode; u16* O; int ldc; float* F0; float* F1; float s;
    float* SSP;
    DI void load_rs(const Unit& u, int wr, int fr, float (&rsum)[8]) const {
        if (SSP && mode != EM_RESID) {
#pragma unroll
            for (int k = 0; k < 8; ++k) rsum[k] = SSP[u.pm * 256 + (k >> 2) * 128 + wr * 64 + (k & 3) * 16 + fr];
        }
    }
    DI float row_rs(float t) const { return SSP ? rsqrtf(t * (1.0f / D) + 1e-5f) : 1.0f; }
    DI void operator()(const f32x4 (&acc)[2][2][4][2], const Unit& u, int wr, int wc, int fr, int fq, const float (&rsum)[8]) const {
        const int row0 = u.pm * 256 + wr * 64 + fr, cin = wc * 32 + 8 * fq;
        if (mode == EM_SWIGLU) {
#pragma unroll
            for (int ai = 0; ai < 2; ++ai)
#pragma unroll
                for (int m = 0; m < 4; ++m) {
                    u16* rowp = O + (size_t)(row0 + ai * 128 + m * 16) * FF + u.pn * 128 + cin;
                    const float rs = row_rs(rsum[ai * 4 + m]);
                    const f32x4 g0 = acc[ai][0][m][0] * rs, g1 = acc[ai][0][m][1] * rs, u0 = acc[ai][1][m][0] * rs, u1 = acc[ai][1][m][1] * rs;
                    u32x4 w;
                    w.x = cvt_pk_bf16(silu_f(g0[0]) * u0[0], silu_f(g0[1]) * u0[1]); w.y = cvt_pk_bf16(silu_f(g0[2]) * u0[2], silu_f(g0[3]) * u0[3]);
                    w.z = cvt_pk_bf16(silu_f(g1[0]) * u1[0], silu_f(g1[1]) * u1[1]); w.w = cvt_pk_bf16(silu_f(g1[2]) * u1[2], silu_f(g1[3]) * u1[3]);
                    *(u32x4*)rowp = w;
                }
        } else if (mode == EM_WINA && u.pn >= 4 && u.pn < 12) {
#pragma unroll
            for (int ai = 0; ai < 2; ++ai)
#pragma unroll
                for (int m = 0; m < 4; ++m) {
                    u16* rowp = O + (size_t)(row0 + ai * 128 + m * 16) * 2560 + 1024 + (u.pn - 4) * 128 + cin;
                    const float rs = row_rs(rsum[ai * 4 + m]), rs2 = rs * rs;
                    const f32x4 u0 = acc[ai][0][m][0] * acc[ai][1][m][0] * rs2, u1 = acc[ai][0][m][1] * acc[ai][1][m][1] * rs2;
                    *(u32x4*)rowp = pack8(u0, u1);
                }
        } else if (mode == EM_RESID && u.part >= 0) {
#pragma unroll
            for (int ai = 0; ai < 2; ++ai)
#pragma unroll
                for (int m = 0; m < 4; ++m) {
                    float* rowp = F1 + ((size_t)u.part * MS + (row0 + ai * 128 + m * 16 - MP)) * D + u.pn * 256 + cin;
#pragma unroll
                    for (int bj = 0; bj < 2; ++bj) { f32x4* p0 = (f32x4*)(rowp + bj * 128); p0[0] = acc[ai][bj][m][0] * s; p0[1] = acc[ai][bj][m][1] * s; }
                }
        } else if (mode == EM_RESID) {
#pragma unroll
            for (int ai = 0; ai < 2; ++ai)
#pragma unroll
                for (int m = 0; m < 4; ++m) {
                    const int row = row0 + ai * 128 + m * 16;
                    u16* rowp = O + (size_t)row * D + u.pn * 256 + cin;
                    float ssq = 0.f;
#pragma unroll
                    for (int bj = 0; bj < 2; ++bj) {
                        const u32x4 xb = *(const u32x4*)(rowp + bj * 128);
                        const f32x4 x0 = (f32x4){bf_lo(xb.x), bf_hi(xb.x), bf_lo(xb.y), bf_hi(xb.y)} + acc[ai][bj][m][0] * s;
                        const f32x4 x1 = (f32x4){bf_lo(xb.z), bf_hi(xb.z), bf_lo(xb.w), bf_hi(xb.w)} + acc[ai][bj][m][1] * s;
                        *(u32x4*)(rowp + bj * 128) = pack8(x0, x1);
                        ssq += (x0[0] * x0[0] + x0[1] * x0[1]) + (x0[2] * x0[2] + x0[3] * x0[3]) + (x1[0] * x1[0] + x1[1] * x1[1]) + (x1[2] * x1[2] + x1[3] * x1[3]);
                    }
                    ssq += __shfl_xor(ssq, 16); ssq += __shfl_xor(ssq, 32);
                    if (fq == 0 && SSP) SSP[(size_t)row * 16 + u.pn * 4 + wc] = ssq;
                }
        } else {
#pragma unroll
            for (int ai = 0; ai < 2; ++ai)
#pragma unroll
                for (int m = 0; m < 4; ++m) {
                    const int r = row0 + ai * 128 + m * 16, col0 = (mode == EM_WINA && u.pn >= 12 ? u.pn - 4 : u.pn) * 256 + cin;
                    u16* rowp = O + (size_t)r * ldc + col0;
                    float* fo = nullptr;
                    if (mode == EM_KV) {
                        if (r < MP) { const int b = r >> 13, t = r & 8191; if (t >= SEQ - 128) fo = F0 + (u.pn ? O_SVP : O_SKP) + (size_t)(b * 128 + (t - (SEQ - 128))) * 256 + cin; }
                        else { const int rs = r - MP, b = rs >> 3, t = rs & 7; fo = F0 + (u.pn ? O_SVS : O_SKS) + (size_t)(b * 128 + 120 + t) * 256 + cin; }
                    } else if (mode == EM_MEMKV) {
                        fo = (col0 < 512 ? F0 + (size_t)r * 512 + col0 : F1 + (size_t)r * 512 + (col0 - 512));
                    }
                    const float rs = row_rs(rsum[ai * 4 + m]);
#pragma unroll
                    for (int bj = 0; bj < 2; ++bj) {
                        const f32x4 v0 = acc[ai][bj][m][0] * rs, v1 = acc[ai][bj][m][1] * rs;
                        u32x4 w; w.x = cvt_pk_bf16(v0[0], v0[1]); w.y = cvt_pk_bf16(v0[2], v0[3]); w.z = cvt_pk_bf16(v1[0], v1[1]); w.w = cvt_pk_bf16(v1[2], v1[3]);
                        *(u32x4*)(rowp + bj * 128) = w;
                        if (fo) { *(f32x4*)(fo + bj * 128) = v0; *(f32x4*)(fo + bj * 128 + 4) = v1; }
                    }
                }
        }
    }
};

DI void wt_tile(const float* __restrict__ src, u16* __restrict__ dst, int K, int N, int mode, int tile, LAS unsigned* T, const float* __restrict__ gain) {
    const int tid = opaque_tid();
    const int nN = N >> 6, nt = tile % nN, kt = tile / nN, k0 = kt * 128, n0 = nt * 64;
    int drow0;
    if (mode == 0) drow0 = n0;
    else if (mode == 3) {
        if (n0 < 1024 || n0 >= 3072) drow0 = n0;
        else if (n0 < 2048) { const int ci = n0 - 1024; drow0 = 1024 + (ci >> 7) * 256 + (ci & 127); }
        else { const int xi = n0 - 2048; drow0 = 1024 + (xi >> 7) * 256 + 128 + (xi & 127); }
    } else drow0 = (n0 >> 7) * 256 + (n0 & 127) + (mode == 2 ? 128 : 0);
#pragma unroll
    for (int pass = 0; pass < 2; ++pass) {
        const int kp = pass * 32 + (tid >> 4), nl = (tid & 15) * 4;
        const float* s = src + (size_t)(k0 + 2 * kp) * N + n0 + nl;
        const float ga = gain ? gain[k0 + 2 * kp] : 1.0f, gb = gain ? gain[k0 + 2 * kp + 1] : 1.0f;
        const f32x4 a = *(const f32x4*)s * ga, b = *(const f32x4*)(s + N) * gb;
        T[(nl + 0) * 65 + kp] = cvt_pk_bf16(a[0], b[0]); T[(nl + 1) * 65 + kp] = cvt_pk_bf16(a[1], b[1]);
        T[(nl + 2) * 65 + kp] = cvt_pk_bf16(a[2], b[2]); T[(nl + 3) * 65 + kp] = cvt_pk_bf16(a[3], b[3]);
    }
    __syncthreads();
    {
        const int n = tid >> 3, c = tid & 7;
        u32x4 w0, w1;
        w0.x = T[n * 65 + c * 8 + 0]; w0.y = T[n * 65 + c * 8 + 1]; w0.z = T[n * 65 + c * 8 + 2]; w0.w = T[n * 65 + c * 8 + 3];
        w1.x = T[n * 65 + c * 8 + 4]; w1.y = T[n * 65 + c * 8 + 5]; w1.z = T[n * 65 + c * 8 + 6]; w1.w = T[n * 65 + c * 8 + 7];
        u16* d = dst + (size_t)(drow0 + n) * K + k0 + c * 16;
        *(u32x4*)d = w0; *(u32x4*)(d + 8) = w1;
    }
    __syncthreads();
}
constexpr int WT_TILES = 11072;
DI void wt_dispatch(const Params& p, int idx, LAS unsigned* T) {
    const float* src; u16* dst; int K, N, mode = 0, tile; const float* gain = nullptr;
    unsigned char* ws = p.ws;
    if (idx < 8960) {
        const int l = idx / 2240, r = idx % 2240; int t = r / 352; if (t > 6) t = 6; tile = r - t * 352;
        if (t == 0) { src = p.in[9] + (size_t)l * D * FF; dst = (u16*)(ws + WS_WGU1 + l * SZ_WGU); K = D; N = FF; mode = 1; gain = p.in[8] + l * D; }
        else if (t == 1) { src = p.in[10] + (size_t)l * D * FF; dst = (u16*)(ws + WS_WGU1 + l * SZ_WGU); K = D; N = FF; mode = 2; gain = p.in[8] + l * D; }
        else if (t == 2) { src = p.in[11] + (size_t)l * D * FF; dst = (u16*)(ws + WS_WD1 + l * SZ_WD); K = FF; N = D; }
        else if (t == 3) { src = p.in[25] + (size_t)l * D * FF; dst = (u16*)(ws + WS_WGU2 + l * SZ_WGU); K = D; N = FF; mode = 1; gain = p.in[24] + l * D; }
        else if (t == 4) { src = p.in[26] + (size_t)l * D * FF; dst = (u16*)(ws + WS_WGU2 + l * SZ_WGU); K = D; N = FF; mode = 2; gain = p.in[24] + l * D; }
        else if (t == 5) { src = p.in[27] + (size_t)l * D * FF; dst = (u16*)(ws + WS_WD2 + l * SZ_WD); K = FF; N = D; }
        else { src = p.in[23] + (size_t)l * D * 1024; dst = (u16*)(ws + WS_WMEM + l * SZ_WMEM); K = D; N = 1024; }
    } else {
        int r = idx - 8960;
        if (r < 896) { const int j = r / 448; tile = r % 448; src = p.in[13] + (size_t)j * D * 3584; dst = (u16*)(ws + WS_WINA + j * SZ_WINA); K = D; N = 3584; mode = 3; gain = p.in[12] + j * D; }
        else if (r < 1280) { r -= 896; const int j = r / 192; tile = r % 192; src = p.in[15] + (size_t)j * 1536 * D; dst = (u16*)(ws + WS_WOUTA + j * SZ_WOUT); K = 1536; N = D; }
        else if (r < 1664) { r -= 1280; const int j = r / 192; tile = r % 192; src = p.in[18] + (size_t)j * D * 1536; dst = (u16*)(ws + WS_WINB + j * SZ_WINB); K = D; N = 1536; gain = p.in[12] + (2 + j) * D; }
        else if (r < 2048) { r -= 1664; const int j = r / 192; tile = r % 192; src = p.in[21] + (size_t)j * 1536 * D; dst = (u16*)(ws + WS_WOUTB + j * SZ_WOUT); K = 1536; N = D; }
        else { tile = r - 2048; src = p.in[17]; dst = (u16*)(ws + WS_WKV); K = D; N = 512; gain = p.in[16]; }
    }
    wt_tile(src, dst, K, N, mode, tile, T, gain);
}

DI void wt_deferred(const Params& p, int l, int s, LAS unsigned* T) {
    const int id = (int)blockIdx.x - 64, n = (int)gridDim.x - 64;
    if (id < 0 || n <= 0) return;
    int lo0 = 0, hi0 = 0, lo1 = 0, hi1 = 0;
    if (s == 1) {
        if (l < 2) { lo0 = 8960 + l * 448; hi0 = lo0 + 448; lo1 = 9856 + l * 192; hi1 = lo1 + 192; }
        else { lo0 = 10240 + (l - 2) * 192; hi0 = lo0 + 192; lo1 = 10624 + (l - 2) * 192; hi1 = lo1 + 192; }
    } else if (s == 5) { lo0 = l * 2240 + 1056; hi0 = lo0 + 1056; }
    else if (l < 3) { lo0 = (l + 1) * 2240; hi0 = lo0 + 1056; if (l == 1) { lo1 = 11008; hi1 = 11072; } }
    for (int idx = lo0 + id; idx < hi0; idx += n) wt_dispatch(p, idx, T);
    for (int idx = lo1 + id; idx < hi1; idx += n) wt_dispatch(p, idx, T);
}

DI void norm_phase(const u16* srcH, const float* srcA, int rowsA, const float* srcB, int nrows, const float* g1, u16* d1, const float* g2, u16* d2, float* ssout, float* fout) {
    const int tid = opaque_tid(), lane = tid & 63, wid = tid >> 6;
    for (int row = blockIdx.x * 8 + wid; row < nrows; row += gridDim.x * 8) {
        f32x4 v[4]; float ss = 0.f;
        if (srcH) {
#pragma unroll
            for (int i = 0; i < 4; ++i) { const u32x2 xb = *(const u32x2*)(srcH + (size_t)row * D + i * 256 + lane * 4); v[i] = (f32x4){bf_lo(xb.x), bf_hi(xb.x), bf_lo(xb.y), bf_hi(xb.y)}; }
        } else {
            const float* s = row < rowsA ? srcA + (size_t)row * D : srcB + (size_t)(row - rowsA) * D;
#pragma unroll
            for (int i = 0; i < 4; ++i) v[i] = *(const f32x4*)(s + i * 256 + lane * 4);
        }
#pragma unroll
        for (int i = 0; i < 4; ++i) ss += v[i][0] * v[i][0] + v[i][1] * v[i][1] + v[i][2] * v[i][2] + v[i][3] * v[i][3];
        ss = wave_sum(ss);
        const float r = rsqrtf(ss * (1.0f / D) + 1e-5f);
        if (ssout) {
            if (lane == 0) ssout[row] = ss;
#pragma unroll
            for (int i = 0; i < 4; ++i) { u32x2 w; w.x = cvt_pk_bf16(v[i][0], v[i][1]); w.y = cvt_pk_bf16(v[i][2], v[i][3]); *(u32x2*)(d1 + (size_t)row * D + i * 256 + lane * 4) = w; }
            continue;
        }
        if (d1) {
#pragma unroll
            for (int i = 0; i < 4; ++i) { const f32x4 g = *(const f32x4*)(g1 + i * 256 + lane * 4); u32x2 w; w.x = cvt_pk_bf16(v[i][0] * r * g[0], v[i][1] * r * g[1]); w.y = cvt_pk_bf16(v[i][2] * r * g[2], v[i][3] * r * g[3]);
                *(u32x2*)(d1 + (size_t)row * D + i * 256 + lane * 4) = w; }
        }
        if (d2) {
#pragma unroll
            for (int i = 0; i < 4; ++i) { const f32x4 g = *(const f32x4*)(g2 + i * 256 + lane * 4); u32x2 w; w.x = cvt_pk_bf16(v[i][0] * r * g[0], v[i][1] * r * g[1]); w.y = cvt_pk_bf16(v[i][2] * r * g[2], v[i][3] * r * g[3]);
                *(u32x2*)(d2 + (size_t)row * D + i * 256 + lane * 4) = w; }
        }
        if (fout) {
#pragma unroll
            for (int i = 0; i < 4; ++i) { const f32x4 g = *(const f32x4*)(g1 + i * 256 + lane * 4); *(f32x4*)(fout + (size_t)row * D + i * 256 + lane * 4) = v[i] * r * g; }
        }
    }
}

template <int HD> DI unsigned k_off(int key, int ch) { const int sw = (HD == 128) ? (key & 15) : ((key >> 1) & 7); return (unsigned)(key * (HD * 2) + ((ch ^ sw) << 4)); }
DI unsigned vt_off(int d, int key) { return (unsigned)(d * 512 + ((((key >> 2) ^ (d & 31))) << 3) + ((key & 3) << 1)); }
DI int crow(int r, int hi) { return (r & 3) + 8 * (r >> 2) + 4 * hi; }
#define MFMA32(a, b, c) __builtin_amdgcn_mfma_f32_32x32x16_bf16((a), (b), (c), 0, 0, 0)

template <int HD, int NKT, class SF>
DI void attn_core(const LAS unsigned char* Kl, const LAS unsigned char* Vl, int kt0, const bf16x8 (&qf)[HD / 16], const SF& sf, float sink, f32x16 (&o)[HD / 32], int lane) {
    const int l31 = lane & 31, half = lane >> 5;
    float m = sink, lsum = 0.f;
#pragma unroll
    for (int dt = 0; dt < HD / 32; ++dt)
#pragma unroll
        for (int r = 0; r < 16; ++r) o[dt][r] = 0.f;
#pragma nounroll
    for (int t = 0; t < NKT; ++t) {
        const int kt = kt0 + t;
        f32x16 st;
#pragma unroll
        for (int r = 0; r < 16; ++r) st[r] = 0.f;
        const int key = 32 * kt + l31;
#pragma unroll
        for (int ks = 0; ks < HD / 16; ++ks) {
            const bf16x8 a = *(const LAS bf16x8*)(Kl + k_off<HD>(key, 2 * ks + half));
            st = MFMA32(a, qf[ks], st);
        }
        float mc = -INFINITY;
#pragma unroll
        for (int r = 0; r < 16; ++r) { const float s = sf(st[r], 32 * kt + crow(r, half)); st[r] = s; mc = fmaxf(mc, s); }
        mc = fmaxf(mc, __shfl_xor(mc, 32));
        const float mn = fmaxf(m, mc);
        const float alpha = __expf(m - mn);
        m = mn;
        lsum *= alpha;
#pragma unroll
        for (int dt = 0; dt < HD / 32; ++dt)
#pragma unroll
            for (int r = 0; r < 16; ++r) o[dt][r] *= alpha;
#pragma unroll
        for (int r = 0; r < 16; ++r) { const float e = __expf(st[r] - mn); st[r] = e; lsum += e; }
#pragma unroll
        for (int k2 = 0; k2 < 2; ++k2) {
            u32x4 pw;
            pw.x = cvt_pk_bf16(st[8 * k2 + 0], st[8 * k2 + 1]); pw.y = cvt_pk_bf16(st[8 * k2 + 2], st[8 * k2 + 3]);
            pw.z = cvt_pk_bf16(st[8 * k2 + 4], st[8 * k2 + 5]); pw.w = cvt_pk_bf16(st[8 * k2 + 6], st[8 * k2 + 7]);
            const bf16x8 pb = __builtin_bit_cast(bf16x8, pw);
            const int kc = 2 * kt + k2;
#pragma unroll
            for (int dt = 0; dt < HD / 32; ++dt) {
                const int d = 32 * dt + l31;
                const s16x4 v0 = *(const LAS s16x4*)(Vl + d * 512 + (((4 * kc + half) ^ l31) << 3));
                const s16x4 v1 = *(const LAS s16x4*)(Vl + d * 512 + (((4 * kc + 2 + half) ^ l31) << 3));
                const bf16x8 a = __builtin_shufflevector(v0, v1, 0, 1, 2, 3, 4, 5, 6, 7);
                o[dt] = MFMA32(a, pb, o[dt]);
            }
        }
    }
    lsum += __shfl_xor(lsum, 32);
    const float inv = 1.0f / (lsum + __expf(sink - m));
#pragma unroll
    for (int dt = 0; dt < HD / 32; ++dt)
#pragma unroll
        for (int r = 0; r < 16; ++r) o[dt][r] *= inv;
}

template <int HD>
DI void attn_store(const f32x16 (&o)[HD / 32], u16* dstrow, int lane) {
    const int half = lane >> 5;
#pragma unroll
    for (int dt = 0; dt < HD / 32; ++dt)
#pragma unroll
        for (int rq = 0; rq < 4; ++rq) {
            u32x2 w; w.x = cvt_pk_bf16(o[dt][4 * rq + 0], o[dt][4 * rq + 1]); w.y = cvt_pk_bf16(o[dt][4 * rq + 2], o[dt][4 * rq + 3]);
            *(u32x2*)(dstrow + 32 * dt + 8 * rq + 4 * half) = w;
        }
}

DI void vt_scatter(LAS unsigned char* Vl, int key, int ch, u32x4 vv) {
#pragma unroll
    for (int j = 0; j < 8; ++j) {
        const unsigned w = (j >> 1) == 0 ? vv.x : ((j >> 1) == 1 ? vv.y : ((j >> 1) == 2 ? vv.z : vv.w));
        const u16 val = (u16)((j & 1) ? (w >> 16) : (w & 0xffffu));
        *(LAS u16*)(Vl + vt_off(ch * 8 + j, key)) = val;
    }
}

DI void memattn_item(int item, LAS unsigned char* lds, const u16* Z, int ldz, int qcol, const u16* memkv_l, const float* ck_l, const float* cv_l, u16* Y) {
    const int tid = opaque_tid(), wid = tid >> 6, lane = tid & 63, l31 = lane & 31, half = lane >> 5;
    LAS unsigned char* Kl = lds; LAS unsigned char* Vl = lds + 65536;
    const bool prompt = item < 256;
    int b, h, qt = 0;
    if (prompt) { b = item >> 7; h = (item >> 5) & 3; qt = item & 31; } else { const int it = item - 256; b = it >> 2; h = it & 3; }
    if (prompt) {
#pragma unroll 2
        for (int i = 0; i < 8; ++i) {
            const int idx = tid + 512 * i, key = idx >> 4, ch = idx & 15;
            const u16* src = memkv_l + (size_t)(b * 256 + key) * 1024 + h * 128 + ch * 8;
            const u32x4 kv = *(const u32x4*)src; const u32x4 vv = *(const u32x4*)(src + 512);
            *(LAS u32x4*)(Kl + k_off<128>(key, ch)) = kv;
            vt_scatter(Vl, key, ch, vv);
        }
    } else {
#pragma unroll 4
        for (int i = 0; i < 8; ++i) {
            const int idx = tid + 512 * i, key = idx >> 4, ch = idx & 15;
            const size_t so = ((size_t)(b * 256 + key) * 4 + h) * 128 + ch * 8;
            const f32x4 k0 = *(const f32x4*)(ck_l + so), k1 = *(const f32x4*)(ck_l + so + 4), v0 = *(const f32x4*)(cv_l + so), v1 = *(const f32x4*)(cv_l + so + 4);
            *(LAS u32x4*)(Kl + k_off<128>(key, ch)) = pack8(k0, k1);
            vt_scatter(Vl, key, ch, pack8(v0, v1));
        }
    }
    __syncthreads();
    if (prompt || wid == 0) {
        const int row = prompt ? (b * SEQ + qt * 256 + wid * 32 + l31) : (MP + b * 8 + (l31 & 7));
        bf16x8 qf[8];
        const u16* qp = Z + (size_t)row * ldz + qcol + h * 128 + 8 * half;
#pragma unroll
        for (int ks = 0; ks < 8; ++ks) qf[ks] = *(const bf16x8*)(qp + 16 * ks);
        f32x16 o[4];
        attn_core<128, 8>(Kl, Vl, 0, qf, [](float s, int) { return s * 0.08838834764831845f; }, -INFINITY, o, lane);
        if (prompt || l31 < 8) attn_store<128>(o, Y + (size_t)row * 1536 + 1024 + h * 128, lane);
    }
    __syncthreads();
}

DI int t5_bucket(int n) {
    if (n < 16) return n;
    int large = 16 + (int)(logf((float)n / 16.0f) / 2.0794415416798357f * 16.0f);
    return large < 31 ? large : 31;
}
DI void swa_item(int item, LAS unsigned char* lds, const u16* Z  , const u16* KVB, const float* cache_k, const float* cache_v, const float* rel_bias, const float* sinks_j, u16* Y) {
    const int tid = opaque_tid(), wid = tid >> 6, lane = tid & 63, l31 = lane & 31;
    LAS unsigned char* Kl = lds; LAS unsigned char* Vl = lds + 32768; LAS float* biasT = (LAS float*)(lds + 65536);
    const bool prompt = item < 512;
    int b, nb = 1, hkv;
    if (prompt) { b = item >> 8; nb = (item >> 2) & 63; hkv = item & 3; } else { const int it = item - 512; b = it >> 2; hkv = it & 3; }
    { const int g = tid >> 7, dist = tid & 127; biasT[tid] = rel_bias[t5_bucket(dist) * 16 + hkv * 4 + g]; }
    if (prompt) {
#pragma unroll 2
        for (int i = 0; i < 4; ++i) {
            const int idx = tid + 512 * i, key = idx >> 3, ch = idx & 7;
            u32x4 kv = (u32x4){0u, 0u, 0u, 0u}, vv = (u32x4){0u, 0u, 0u, 0u};
            if (nb > 0 || key >= 128) { const u16* src = KVB + (size_t)(b * SEQ + (nb - 1) * 128 + key) * 512 + hkv * 64 + ch * 8; kv = *(const u32x4*)src; vv = *(const u32x4*)(src + 256); }
            *(LAS u32x4*)(Kl + k_off<64>(key, ch)) = kv;
            vt_scatter(Vl, key, ch, vv);
        }
    } else {
#pragma nounroll
        for (int i = 0; i < 3; ++i) {
            const int idx = tid + 512 * i, key = idx >> 3, ch = idx & 7;
            if (key < 160) {
                u32x4 kv = (u32x4){0u, 0u, 0u, 0u}, vv = (u32x4){0u, 0u, 0u, 0u};
                if (key < 128) {
                    const size_t so = ((size_t)(b * 128 + key) * 4 + hkv) * 64 + ch * 8;
                    kv = pack8(*(const f32x4*)(cache_k + so), *(const f32x4*)(cache_k + so + 4));
                    vv = pack8(*(const f32x4*)(cache_v + so), *(const f32x4*)(cache_v + so + 4));
                } else if (key < 136) { const u16* src = KVB + (size_t)(MP + b * 8 + (key - 128)) * 512 + hkv * 64 + ch * 8; kv = *(const u32x4*)src; vv = *(const u32x4*)(src + 256); }
                *(LAS u32x4*)(Kl + k_off<64>(key, ch)) = kv;
                vt_scatter(Vl, key, ch, vv);
            }
        }
    }
    __syncthreads();
    const int ntask = prompt ? 2 : (wid == 0 ? 1 : 0);
    for (int task = 0; task < ntask; ++task) {
        int g, qi, row, kt0, jmin;
        if (prompt) { g = wid >> 1; qi = (wid & 1) * 64 + task * 32 + l31; row = b * SEQ + nb * 128 + qi; kt0 = (wid & 1) * 2 + task; jmin = nb > 0 ? 0 : 128; }
        else { g = l31 >> 3; qi = l31 & 7; row = MP + b * 8 + qi; kt0 = 0; jmin = 0; }
        const int head = hkv * 4 + g;
        bf16x8 qf[4];
        const u16* qp = Z + (size_t)row * 1536 + head * 64 + 8 * (lane >> 5);
#pragma unroll
        for (int ks = 0; ks < 4; ++ks) qf[ks] = *(const bf16x8*)(qp + 16 * ks);
        const float sink = sinks_j[head];
        f32x16 o[2];
        const LAS float* bt = biasT + g * 128;
        attn_core<64, 5>(Kl, Vl, kt0, qf, [=](float s, int j) { const int dist = 128 + qi - j; const bool ok = ((unsigned)dist < 128u) && (j >= jmin); return ok ? s * 0.125f + bt[dist & 127] : -INFINITY; }, sink, o, lane);
        attn_store<64>(o, Y + (size_t)row * 1536 + head * 64, lane);
    }
    __syncthreads();
}

DI void conv_item(int item, const u16* Z  , u16* Y, const float* convw, const float* state_l, float* csp_l, float* css_l) {
    const int tid = opaque_tid(), chunk = tid >> 7, c0 = (tid & 127) * 8;
    const int r0 = item * 32 + chunk * 8;
    const bool sample = r0 >= MP;
    float u1[8], u2[8], w0[8], w1[8], w2[8];
    {
        const f32x4 a0 = *(const f32x4*)(convw + c0), a1 = *(const f32x4*)(convw + c0 + 4), b0 = *(const f32x4*)(convw + D + c0), b1 = *(const f32x4*)(convw + D + c0 + 4),
                    d0 = *(const f32x4*)(convw + 2 * D + c0), d1 = *(const f32x4*)(convw + 2 * D + c0 + 4);
#pragma unroll
        for (int j = 0; j < 4; ++j) { w0[j] = a0[j]; w0[j + 4] = a1[j]; w1[j] = b0[j]; w1[j + 4] = b1[j]; w2[j] = d0[j]; w2[j + 4] = d1[j]; }
    }
    int bs = 0;
    if (!sample) {
        if ((r0 & (SEQ - 1)) == 0) {
#pragma unroll
            for (int j = 0; j < 8; ++j) { u1[j] = 0.f; u2[j] = 0.f; }
        } else {
            const u32x4 q2 = *(const u32x4*)(Z + (size_t)(r0 - 2) * 2560 + 1024 + c0), q1 = *(const u32x4*)(Z + (size_t)(r0 - 1) * 2560 + 1024 + c0);
            u2[0] = bf_lo(q2.x); u2[1] = bf_hi(q2.x); u2[2] = bf_lo(q2.y); u2[3] = bf_hi(q2.y); u2[4] = bf_lo(q2.z); u2[5] = bf_hi(q2.z); u2[6] = bf_lo(q2.w); u2[7] = bf_hi(q2.w);
            u1[0] = bf_lo(q1.x); u1[1] = bf_hi(q1.x); u1[2] = bf_lo(q1.y); u1[3] = bf_hi(q1.y); u1[4] = bf_lo(q1.z); u1[5] = bf_hi(q1.z); u1[6] = bf_lo(q1.w); u1[7] = bf_hi(q1.w);
        }
    } else {
        bs = (r0 - MP) >> 3;
        const float* s2 = state_l + (size_t)(bs * 2) * D + c0; const float* s1 = s2 + D;
        const f32x4 p0 = *(const f32x4*)s2, p1 = *(const f32x4*)(s2 + 4), q0 = *(const f32x4*)s1, q1 = *(const f32x4*)(s1 + 4);
#pragma unroll
        for (int j = 0; j < 4; ++j) { u2[j] = p0[j]; u2[j + 4] = p1[j]; u1[j] = q0[j]; u1[j + 4] = q1[j]; }
    }
#pragma unroll
    for (int i = 0; i < 8; ++i) {
        const u16* z = Z + (size_t)(r0 + i) * 2560 + c0;
        const u32x4 bg = *(const u32x4*)z, ug = *(const u32x4*)(z + 1024);
        float u0[8], bb[8];
        u0[0] = bf_lo(ug.x); u0[1] = bf_hi(ug.x); u0[2] = bf_lo(ug.y); u0[3] = bf_hi(ug.y); u0[4] = bf_lo(ug.z); u0[5] = bf_hi(ug.z); u0[6] = bf_lo(ug.w); u0[7] = bf_hi(ug.w);
        bb[0] = bf_lo(bg.x); bb[1] = bf_hi(bg.x); bb[2] = bf_lo(bg.y); bb[3] = bf_hi(bg.y); bb[4] = bf_lo(bg.z); bb[5] = bf_hi(bg.z); bb[6] = bf_lo(bg.w); bb[7] = bf_hi(bg.w);
        float y[8];
#pragma unroll
        for (int j = 0; j < 8; ++j) { y[j] = bb[j] * (w0[j] * u2[j] + w1[j] * u1[j] + w2[j] * u0[j]); u2[j] = u1[j]; u1[j] = u0[j]; }
        u32x4 w; w.x = cvt_pk_bf16(y[0], y[1]); w.y = cvt_pk_bf16(y[2], y[3]); w.z = cvt_pk_bf16(y[4], y[5]); w.w = cvt_pk_bf16(y[6], y[7]);
        *(u32x4*)(Y + (size_t)(r0 + i) * 1536 + c0) = w;
    }
    float* so = nullptr;
    if (!sample) { if ((r0 & (SEQ - 1)) == SEQ - 8) so = csp_l + (size_t)((r0 >> 13) * 2) * D + c0; }
    else so = css_l + (size_t)(bs * 2) * D + c0;
    if (so) {
        *(f32x4*)so = (f32x4){u2[0], u2[1], u2[2], u2[3]}; *(f32x4*)(so + 4) = (f32x4){u2[4], u2[5], u2[6], u2[7]};
        *(f32x4*)(so + D) = (f32x4){u1[0], u1[1], u1[2], u1[3]}; *(f32x4*)(so + D + 4) = (f32x4){u1[4], u1[5], u1[6], u1[7]};
    }
}

DI void resid_finalize(u16* XB, const float* P, float* ssw, const float* ssq) {
    const int tid = opaque_tid(), lane = tid & 63, wid = tid >> 6;
    for (int row = blockIdx.x * NTHR + tid; row < MP; row += gridDim.x * NTHR) {
        const f32x4* q = (const f32x4*)(ssq + (size_t)row * 16); const f32x4 a = q[0], b = q[1], c = q[2], d = q[3];
        ssw[row] = (((a[0] + a[1]) + (a[2] + a[3])) + ((b[0] + b[1]) + (b[2] + b[3]))) + (((c[0] + c[1]) + (c[2] + c[3])) + ((d[0] + d[1]) + (d[2] + d[3])));
    }
    for (int row = blockIdx.x * 8 + wid; row < MT; row += gridDim.x * 8) {
        if (row < MP) continue;
        u16* xr = XB + (size_t)row * D;
        float ss = 0.f;
#pragma unroll
        for (int i = 0; i < 4; ++i) {
            const u32x2 xb = *(const u32x2*)(xr + i * 256 + lane * 4);
            f32x4 v = (f32x4){bf_lo(xb.x), bf_hi(xb.x), bf_lo(xb.y), bf_hi(xb.y)};
#pragma unroll
            for (int sp = 0; sp < NSPLIT; ++sp) v = v + *(const f32x4*)(P + ((size_t)sp * MS + (row - MP)) * D + i * 256 + lane * 4);
            ss += v[0] * v[0] + v[1] * v[1] + v[2] * v[2] + v[3] * v[3];
            u32x2 w; w.x = cvt_pk_bf16(v[0], v[1]); w.y = cvt_pk_bf16(v[2], v[3]);
            *(u32x2*)(xr + i * 256 + lane * 4) = w;
        }
        ss = wave_sum(ss);
        if (lane == 0) ssw[row] = ss;
    }
}

struct GemmDesc { const u16* A; const u16* Bt; int M, N, K, G, c, ns; Epi E; };
DI bool make_gemm(const Params& p, int l, int s, int gi, GemmDesc& d) {
    unsigned char* ws = p.ws;
    const int G = gridDim.x, bid = blockIdx.x;
    u16* XN = (u16*)(ws + WS_XN); u16* H = (u16*)(ws + WS_H);
    d.M = MT; d.K = D; d.G = G; d.c = bid; d.ns = 0; d.E.O = nullptr; d.E.ldc = 0; d.E.F0 = nullptr; d.E.F1 = nullptr; d.E.s = 1.0f;
    d.E.SSP = nullptr;
    float* SSP = (float*)(ws + WS_SSP);
    const float* ssr = (s == 0) ? (l == 0 ? SSP + (size_t)12 * MT : SSP + (size_t)(3 * l - 1) * MT) : SSP + (size_t)(3 * l + 1) * MT;
    if (s == 0 || s == 7) {
        if (gi == 0) { d.A = XN; d.Bt = (const u16*)(ws + (s == 0 ? WS_WGU1 : WS_WGU2) + l * SZ_WGU); d.N = 5632; d.E.mode = EM_SWIGLU; d.E.O = H; d.E.SSP = (float*)ssr; return true; }
        if (gi == 1 && s == 0 && l == 0) {
            const int c = bid - (G - 32); const int ml = c >= 0 ? (c >> 3) : 0;
            d.A = (const u16*)(ws + WS_MEMN) + (size_t)ml * 512 * 1024; d.Bt = (const u16*)(ws + WS_WMEM + ml * SZ_WMEM); d.M = 512; d.N = 1024; d.G = 8; d.c = c >= 0 ? (c & 7) : -1;
            d.E.mode = EM_MEMKV; d.E.O = (u16*)(ws + WS_MEMKV) + (size_t)ml * 512 * 1024; d.E.ldc = 1024; d.E.F0 = p.out + O_MKP + (size_t)ml * 512 * 512; d.E.F1 = p.out + O_MVP + (size_t)ml * 512 * 512; return true; }
        if (gi == 1 && s == 0 && l == 2) {
            d.A = XN; d.Bt = (const u16*)(ws + WS_WKV); d.N = 512; d.E.mode = EM_KV; d.E.O = (u16*)(ws + WS_KVB); d.E.ldc = 512; d.E.F0 = p.out; d.E.SSP = SSP + (size_t)5 * MT; return true; }
        return false;
    }
    if (gi != 0) return false;
    if (s == 1 || s == 8) { d.A = H; d.K = FF; d.Bt = (const u16*)(ws + (s == 1 ? WS_WD1 : WS_WD2) + l * SZ_WD); d.N = D; d.E.mode = EM_RESID; d.E.O = XN; d.E.s = 0.5f; d.E.SSP = (float*)(ws + WS_SSQ); d.ns = NSPLIT; d.E.F1 = (float*)(ws + WS_P); return true; }
    if (s == 5) { d.A = (const u16*)(ws + WS_Y); d.K = 1536; d.Bt = (const u16*)(ws + (l < 2 ? WS_WOUTA + l * SZ_WOUT : WS_WOUTB + (l - 2) * SZ_WOUT)); d.N = D; d.E.mode = EM_RESID; d.E.O = XN; d.E.SSP = (float*)(ws + WS_SSQ); d.ns = NSPLIT; d.E.F1 = (float*)(ws + WS_P); return true; }
    if (s == 3) { const int N = l < 2 ? 3584 : 1536; d.A = XN; d.Bt = (const u16*)(ws + (l < 2 ? WS_WINA + l * SZ_WINA : WS_WINB + (l - 2) * SZ_WINB)); d.N = N; d.E.mode = l < 2 ? EM_WINA : EM_BF16; d.E.O = (u16*)(ws + WS_Z); d.E.ldc = l < 2 ? 2560 : N; d.E.SSP = SSP + (size_t)(3 * l) * MT; return true; }
    return false;
}

DI void run_phase(const Params& p, int ph, LAS unsigned char* lds, int rep) {
    unsigned char* ws = p.ws;
    u16* XN = (u16*)(ws + WS_XN);
    const int G = gridDim.x, bid = blockIdx.x;
    const int l = ph == 0 ? 0 : (ph - 1) / 10, s = ph == 0 ? -1 : (ph - 1) % 10;
    if (ph == 0) {
        for (int idx = bid; idx < 1056 + 4 * 128; idx += G) wt_dispatch(p, idx < 1056 ? idx : ((idx - 1056) >> 7) * 2240 + 2112 + ((idx - 1056) & 127), (LAS unsigned*)lds);
    }
    if (s == 2 || s == 6 || s == 9) {
        float* SSP = (float*)(ws + WS_SSP);
        resid_finalize(XN, (const float*)(ws + WS_P), SSP + (size_t)(3 * l + (s == 2 ? 0 : (s == 6 ? 1 : 2))) * MT, (const float*)(ws + WS_SSQ));
        if (!(s == 9 && l == 3)) return;
    }
    if (ph == 0 || (s == 9 && l == 3)) {
        for (int pass = 0; pass < (ph == 0 ? 3 : 1); ++pass) {
            const u16* srcH = nullptr; const float* srcA = nullptr; const float* srcB = nullptr; int rowsA = MT, nrows = MT; const float* g1 = nullptr; u16* d1 = XN; const float* g2 = nullptr; u16* d2 = nullptr; float* sso = nullptr; float* fo = nullptr;
            if (ph == 0) {
                if (pass < 2) { srcA = srcB = p.in[7]; rowsA = nrows = 512; g1 = p.in[22] + (2 * pass) * D; g2 = g1 + D; d1 = (u16*)(ws + WS_MEMN) + (size_t)(2 * pass) * 512 * 1024; d2 = d1 + 512 * 1024; }
                else { srcA = p.in[0]; srcB = p.in[1]; rowsA = MP; sso = (float*)(ws + WS_SSP) + (size_t)12 * MT; }
            } else { srcH = XN; g1 = p.in[28]; d1 = nullptr; fo = p.out + O_Y; }
            norm_phase(srcH, srcA, rowsA, srcB, nrows, g1, d1, g2, d2, sso, fo);
        }
        return;
    }
    if (s == 4) {
        u16* Z = (u16*)(ws + WS_Z); u16* Y = (u16*)(ws + WS_Y);
        const int ldz = l < 2 ? 2560 : 1536, qcol = l < 2 ? 2048 : 1024;
        const u16* memkv_l = (const u16*)(ws + WS_MEMKV) + (size_t)l * 512 * 1024;
        const float* ck_l = p.in[5] + (size_t)l * 128 * 256 * 512; const float* cv_l = p.in[6] + (size_t)l * 128 * 256 * 512;
        const int nitems = l < 2 ? 768 + 544 : 768 + 1024;
        const int nround = (nitems + G - 1) / G, shift = (bid % 3 == 0) ? 0 : (bid % 3 == 1 ? 1 : 3);
        for (int k = 0; k < nround; ++k) {
            const int it = bid + ((k + shift) % nround) * G;
            if (it >= nitems) continue;
            if (it < 768) memattn_item(it, lds, Z, ldz, qcol, memkv_l, ck_l, cv_l, Y);
            else if (l < 2) conv_item(it - 768, Z, Y, p.in[14] + (size_t)l * 3 * D, p.in[2] + (size_t)l * 128 * 2 * D, p.out + O_CSP + (size_t)l * 2 * 2 * D, p.out + O_CSS + (size_t)l * 128 * 2 * D);
            else swa_item(it - 768, lds, Z, (const u16*)(ws + WS_KVB), p.in[3], p.in[4], p.in[20], p.in[19] + (l - 2) * 16, Y);
        }
        return;
    }
    for (int gi = 0; gi < 2; ++gi) {
        GemmDesc d;
        if (!make_gemm(p, l, s, gi, d)) break;
        if (rep && d.E.mode == EM_RESID) { d.E.s = 0.f; d.E.SSP = nullptr; }
        pg8::Gemm g{d.A, d.Bt, d.M, d.N, d.K}; pg8::StaticOrder S; S.init(d.M, d.N, d.K, d.G, d.c, d.ns);
        pg8::gemm_phase(lds, g, S, d.E);
    }
    if (s == 1 || s == 5 || s == 8) wt_deferred(p, l, s, (LAS unsigned*)lds);
    if (s == 5 && l == 0 && (int)blockIdx.x >= 64) {
        const size_t n4 = (size_t)128 * 30720 / 4;
        for (size_t e = (size_t)(bid - 64) * NTHR + opaque_tid(); e < n4; e += (size_t)(G - 64) * NTHR) {
            const size_t f = e * 4, b = f / 30720, rem = f % 30720;
            *(f32x4*)(p.out + O_SKS + b * 32768 + rem) = *(const f32x4*)(p.in[3] + b * 32768 + 2048 + rem);
            *(f32x4*)(p.out + O_SVS + b * 32768 + rem) = *(const f32x4*)(p.in[4] + b * 32768 + 2048 + rem);
        }
    }
}

__host__ __device__ inline bool phase_skipped(int ph) { if (ph == 0) return false; const int l = (ph - 1) / 10, s = (ph - 1) % 10; (void)l; (void)s; return false; }
__global__ void __launch_bounds__(NTHR, 2) mega(Params p) {
    extern __shared__ __attribute__((aligned(16))) unsigned char shm[];
    LAS unsigned char* lds = (LAS unsigned char*)shm;
    volatile LAS unsigned* st = (volatile LAS unsigned*)(lds + STAGE_BYTES);
    if (threadIdx.x < 4) st[threadIdx.x] = 0u;
    __syncthreads();
    XcdBarrier bar; bar.bar = (unsigned*)(p.ws + WS_BAR); bar.x = 0; bar.st = st;
    if (p.ph_hi - p.ph_lo > 1) bar = xcd_barrier_post((unsigned*)(p.ws + WS_BAR), st);
    for (int ph = p.ph_lo; ph < p.ph_hi; ++ph) {
        if (phase_skipped(ph)) continue;
        const int reps = (DUP_MASK != 0 && ((DUP_MASK >> (ph == 0 ? 10 : (ph - 1) % 10)) & 1)) ? 2 : 1;
        for (int rep = 0; rep < reps; ++rep) { run_phase(p, ph, lds, rep); if (DUP_BAR && rep + 1 < reps) xcd_barrier(bar); }
        if (ph + 1 < p.ph_hi) {
            if (ph == p.ph_lo) cg::this_grid().sync();
            else xcd_barrier(bar);
        }
    }
}

extern "C" void kernel_launch(void* const* d_in, const int* in_sizes, int n_in, void* d_out, int out_size, void* d_ws, size_t ws_size, hipStream_t stream) {
    static int grid = 0;
    if (grid == 0) {
        int dev = 0, cus = 0, per_cu = 0;
        hipGetDevice(&dev);
        hipDeviceGetAttribute(&cus, hipDeviceAttributeMultiprocessorCount, dev);
        hipFuncSetAttribute((const void*)mega, hipFuncAttributeMaxDynamicSharedMemorySize, LDS_BYTES);
        hipOccupancyMaxActiveBlocksPerMultiprocessor(&per_cu, (const void*)mega, NTHR, LDS_BYTES);
        if (per_cu < 1) per_cu = 1;
        grid = cus * 1;
        if (ws_size < WS_END) { fprintf(stderr, "kernel_launch: workspace too small (%zu < %zu)\n", ws_size, (size_t)WS_END); }
        (void)hipGetLastError();
    }
    Params p{};
    (void)hipMemsetAsync((unsigned char*)d_ws + WS_BAR, 0, 16384, stream);
    for (int i = 0; i < 29; ++i) p.in[i] = (const float*)d_in[i];
    p.out = (float*)d_out; p.ws = (unsigned char*)d_ws;
#if ONE_LAUNCH
    p.ph_lo = 0; p.ph_hi = NPHASE;
    void* args[] = {&p};
    hipError_t e = hipLaunchCooperativeKernel((const void*)mega, dim3(grid), dim3(NTHR), args, LDS_BYTES, stream);
    if (e != hipSuccess) fprintf(stderr, "cooperative launch failed: %s (grid %d)\n", hipGetErrorString(e), grid);
#else
    for (int ph = 0; ph < NPHASE; ++ph) {
        if (phase_skipped(ph)) continue;
        p.ph_lo = ph; p.ph_hi = ph + 1;
        hipLaunchKernelGGL(mega, dim3(grid), dim3(NTHR), LDS_BYTES, stream, p);
    }
#endif
}
```
